# Optimizing an MI355X kernel written in HIP

```python
import math
import jax, jax.numpy as jnp
from jax import lax
import numpy as np

D_MODEL = 1024
BATCH = 4
SEQ = 4096
DEPTH = 1

CHUNK = 64
Q_BLOCK = 128
ROPE_THETA = 10000.0
NORM_EPS = 1e-6
SUBLN_EPS = 1e-5
DA_HEAD_DIM = 64
DA_HEADS = D_MODEL // 256
DA_WIDTH = DA_HEADS * 2 * DA_HEAD_DIM
RWKV_HEAD = 64
RWKV_HEADS = D_MODEL // 128
RWKV_WIDTH = RWKV_HEADS * RWKV_HEAD
DECAY_LORA = 64
AAA_LORA = 64
GATE_LORA = 128
GN_EPS = 64e-5
RWKV_COLS = 3 * RWKV_WIDTH + DECAY_LORA + AAA_LORA + GATE_LORA
IN_COLS = 3 * DA_WIDTH + RWKV_COLS
N_EXPERTS = 256
TOP_K = 8
N_GROUPS = 8
TOPK_GROUPS = 4
EXPERT_HIDDEN = D_MODEL // 4
ROUTED_SCALE = 2.5
MOE_BLOCK = 128

kernel_name = 'hybrid_diffattn_rwkv7_moe_block'


def rms_norm(x, g, eps):
    xf = x.astype(jnp.float32)
    y = xf * lax.rsqrt(jnp.mean(xf * xf, axis=-1, keepdims=True) + eps)
    return (y * g.astype(jnp.float32)).astype(x.dtype)


def rope(x, positions):
    d = x.shape[-1]
    inv_freq = 1.0 / (ROPE_THETA ** (jnp.arange(0, d, 2, dtype=jnp.float32) / d))
    ang = positions.astype(jnp.float32)[:, :, None] * inv_freq
    cos = jnp.cos(ang)[:, :, None, :]
    sin = jnp.sin(ang)[:, :, None, :]
    xf = x.astype(jnp.float32)
    x1, x2 = xf[..., : d // 2], xf[..., d // 2:]
    return jnp.concatenate([x1 * cos - x2 * sin, x2 * cos + x1 * sin], axis=-1).astype(x.dtype)


def token_shift(p, mu):
    prev = jnp.pad(p, ((0, 0), (1, 0), (0, 0)))[:, :-1]
    return p + (prev - p) * mu


def diff_attention(pq, pk, pv, positions, q_norm_g, k_norm_g, lambda_q1, lambda_k1,
                   lambda_q2, lambda_k2, subln_g, lambda_init):
    B, S, _ = pq.shape
    H, d = DA_HEADS, DA_HEAD_DIM
    q = rope(rms_norm(pq.reshape(B, S, 2 * H, d), q_norm_g, NORM_EPS), positions)
    k = rope(rms_norm(pk.reshape(B, S, 2 * H, d), k_norm_g, NORM_EPS), positions)
    q = q.reshape(B, S, H, 2, d).transpose(0, 2, 3, 1, 4)
    k = k.reshape(B, S, H, 2, d).transpose(0, 2, 3, 1, 4)
    v = pv.reshape(B, S, H, 2 * d).transpose(0, 2, 1, 3)
    f32 = jnp.float32
    lam = (jnp.exp(jnp.sum(lambda_q1.astype(f32) * lambda_k1.astype(f32)))
           - jnp.exp(jnp.sum(lambda_q2.astype(f32) * lambda_k2.astype(f32))) + lambda_init)
    scale = d ** -0.5
    outs = []
    for i in range(S // Q_BLOCK):
        q0 = i * Q_BLOCK
        kv_len = q0 + Q_BLOCK
        qb = q[:, :, :, q0:kv_len]
        kb = k[:, :, :, :kv_len]
        vb = v[:, :, :kv_len]
        s = jnp.einsum('bhmqd,bhmkd->bhmqk', qb, kb).astype(f32) * scale
        q_chunk = (q0 + jnp.arange(Q_BLOCK)) // CHUNK
        k_chunk = jnp.arange(kv_len) // CHUNK
        mask = k_chunk[None, :] <= q_chunk[:, None]
        p = jax.nn.softmax(jnp.where(mask, s, -jnp.inf), axis=-1)
        a = p[:, :, 0] - lam * p[:, :, 1]
        outs.append(jnp.einsum('bhqk,bhkv->bhqv', a.astype(vb.dtype), vb))
    o = jnp.concatenate(outs, axis=2)
    o = rms_norm(o, subln_g, SUBLN_EPS) * (1.0 - lambda_init)
    return o.transpose(0, 2, 1, 3).reshape(B, S, H * 2 * d)


def rwkv7_time_mix(p, mu, w_decay0, w_decay2, a0, a2, g2, k_k, k_a, r_k, ln_x_w, ln_x_b):
    B, S, _ = p.shape
    H, N = RWKV_HEADS, RWKV_HEAD
    f32 = jnp.float32
    xs = token_shift(p, mu)
    c1 = RWKV_WIDTH
    xr, xk, xv, xw, xa, xg = jnp.split(
        xs, [c1, 2 * c1, 3 * c1, 3 * c1 + DECAY_LORA, 3 * c1 + DECAY_LORA + AAA_LORA], axis=-1)
    w = -jax.nn.softplus(-(w_decay0 + jnp.tanh(xw) @ w_decay2)) - 0.5
    a = jax.nn.sigmoid(a0 + xa @ a2)
    g = jax.nn.sigmoid(xg) @ g2
    heads = lambda t: t.astype(f32).reshape(B, S, H, N)
    r, k, v, a, w = heads(xr), heads(xk), heads(xv), heads(a), heads(w)
    kk = k * k_k.astype(f32).reshape(H, N)
    kk = kk / jnp.maximum(jnp.linalg.norm(kk, axis=-1, keepdims=True), 1e-12)
    k = k * (1.0 + (a - 1.0) * k_a.astype(f32).reshape(H, N))
    decay = jnp.exp(-jnp.exp(w))

    def step(state, inp):
        r_t, d_t, k_t, v_t, kk_t, a_t = inp
        sa = jnp.einsum('bhvk,bhk->bhv', state, -kk_t)
        state = (state * d_t[:, :, None, :] + sa[..., None] * (kk_t * a_t)[:, :, None, :]
                 + v_t[..., None] * k_t[:, :, None, :])
        return state, jnp.einsum('bhvk,bhk->bhv', state, r_t)

    seq_first = lambda t: jnp.swapaxes(t, 0, 1)
    state0 = jnp.zeros((B, H, N, N), f32)
    _, y = lax.scan(step, state0, (seq_first(r), seq_first(decay), seq_first(k),
                                   seq_first(v), seq_first(kk), seq_first(a)))
    y = seq_first(y)
    mean = jnp.mean(y, axis=-1, keepdims=True)
    var = jnp.mean(jnp.square(y - mean), axis=-1, keepdims=True)
    y = ((y - mean) * lax.rsqrt(var + GN_EPS)).reshape(B, S, RWKV_WIDTH)
    y = y * ln_x_w.astype(f32) + ln_x_b.astype(f32)
    bonus = jnp.sum(r * k * r_k.astype(f32), axis=-1, keepdims=True) * v
    y = (y + bonus.reshape(B, S, RWKV_WIDTH)) * g.astype(f32)
    return y.astype(p.dtype)


def moe_ffn(h, w_router, router_bias, w_expert_up_gate, w_expert_down, w_shared_up_gate, w_shared_down):
    B, S, D = h.shape
    n_tok = B * S
    F = w_expert_down.shape[1]
    f32 = jnp.float32
    hf = h.reshape(n_tok, D)
    scores = jax.nn.sigmoid((hf @ w_router).astype(f32))
    biased = scores + router_bias.astype(f32)
    grp = biased.reshape(n_tok, N_GROUPS, N_EXPERTS // N_GROUPS)
    grp_score = jnp.sum(lax.top_k(grp, 2)[0], axis=-1)
    _, gidx = lax.top_k(grp_score, TOPK_GROUPS)
    gmask = jnp.sum(jax.nn.one_hot(gidx, N_GROUPS, dtype=f32), axis=-2) > 0
    emask = jnp.repeat(gmask, N_EXPERTS // N_GROUPS, axis=-1)
    _, eidx = lax.top_k(jnp.where(emask, biased, -jnp.inf), TOP_K)
    wts = jnp.take_along_axis(scores, eidx, axis=-1)
    wts = wts / jnp.sum(wts, axis=-1, keepdims=True) * ROUTED_SCALE

    nk = n_tok * TOP_K
    flat_e = eidx.reshape(nk)
    flat_tok = (jnp.arange(nk) // TOP_K).astype(jnp.int32)
    flat_w = wts.reshape(nk)
    order = jnp.argsort(flat_e)
    sorted_e = flat_e[order]
    counts = jnp.bincount(flat_e, length=N_EXPERTS)
    offsets = jnp.cumsum(counts) - counts
    pcounts = (counts + MOE_BLOCK - 1) // MOE_BLOCK * MOE_BLOCK
    pends = jnp.cumsum(pcounts)
    pstarts = pends - pcounts
    dest = pstarts[sorted_e] + (jnp.arange(nk) - offsets[sorted_e])
    n_rows = (nk + N_EXPERTS * (MOE_BLOCK - 1) + MOE_BLOCK - 1) // MOE_BLOCK * MOE_BLOCK
    n_blocks = n_rows // MOE_BLOCK
    row_tok = jnp.zeros((n_rows,), jnp.int32).at[dest].set(flat_tok[order])
    row_w = jnp.zeros((n_rows,), flat_w.dtype).at[dest].set(flat_w[order])
    block_start = jnp.arange(n_blocks) * MOE_BLOCK
    block_e = jnp.minimum(jnp.searchsorted(pends, block_start, side='right'), N_EXPERTS - 1)

    def body(acc, blk):
        tok, w, e = blk
        xb = hf[tok]
        gu = xb @ w_expert_up_gate[e]
        hid = jax.nn.silu(gu[:, :F]) * gu[:, F:]
        yb = hid @ w_expert_down[e]
        return acc.at[tok].add((yb * w[:, None]).astype(acc.dtype)), None

    routed, _ = lax.scan(body, jnp.zeros_like(hf),
                         (row_tok.reshape(n_blocks, MOE_BLOCK), row_w.reshape(n_blocks, MOE_BLOCK), block_e))
    gu = hf @ w_shared_up_gate
    shared = (jax.nn.silu(gu[:, :F]) * gu[:, F:]) @ w_shared_down
    return (shared + routed).reshape(B, S, D)


def hybrid_layer(x, c, positions, layer_idx, w_ada, b_ada, norm1_g, w_in, w_gate, b_gate,
                 q_norm_g, k_norm_g, lambda_q1, lambda_k1, lambda_q2, lambda_k2, subln_g,
                 rwkv_mu, w_decay0, w_decay2, a0, a2, g2, k_k, k_a, r_k, ln_x_w, ln_x_b,
                 w_branch_a, w_branch_b, w_out, norm2_g, w_router, router_bias,
                 w_expert_up_gate, w_expert_down, w_shared_up_gate, w_shared_down):
    mod = jax.nn.silu(c) @ w_ada + b_ada
    sh1, sc1, gt1, sh2, sc2, gt2 = [m[:, None, :] for m in jnp.split(mod, 6, axis=-1)]
    h = rms_norm(x, norm1_g, NORM_EPS) * (1.0 + sc1) + sh1
    proj = h @ w_in
    pq, pk, pv, prw = jnp.split(proj, [DA_WIDTH, 2 * DA_WIDTH, 3 * DA_WIDTH], axis=-1)
    lambda_init = 0.8 - 0.6 * math.exp(-0.3 * layer_idx)
    ya = diff_attention(pq, pk, pv, positions, q_norm_g, k_norm_g, lambda_q1, lambda_k1,
                        lambda_q2, lambda_k2, subln_g, lambda_init) @ w_branch_a
    yb = rwkv7_time_mix(prw, rwkv_mu, w_decay0, w_decay2, a0, a2, g2, k_k, k_a, r_k,
                        ln_x_w, ln_x_b) @ w_branch_b
    ga, gb = jnp.split(jax.nn.sigmoid(h @ w_gate + b_gate), 2, axis=-1)
    x = x + gt1 * ((ga * ya + gb * yb) @ w_out)
    h2 = rms_norm(x, norm2_g, NORM_EPS) * (1.0 + sc2) + sh2
    x = x + gt2 * moe_ffn(h2, w_router, router_bias, w_expert_up_gate, w_expert_down,
                          w_shared_up_gate, w_shared_down)
    return x


def setup_inputs(seed: int = 0) -> dict:
    key = jax.random.key(seed)
    ks = iter(jax.random.split(key, 48))
    f32 = jnp.float32
    L, D, F, E = DEPTH, D_MODEL, EXPERT_HIDDEN, N_EXPERTS
    nrm = lambda shape, s: jax.random.normal(next(ks), shape, f32) * s
    gain = lambda shape: 1.0 + jax.random.normal(next(ks), shape, f32) * 0.02
    x = jax.random.normal(next(ks), (BATCH, SEQ, D), f32)
    c = jax.random.normal(next(ks), (BATCH, D), f32)
    offset = jax.random.randint(next(ks), (BATCH, 1), 0, 1024) * CHUNK
    positions = (offset + jnp.arange(SEQ)[None, :]).astype(jnp.int32)
    return {
        'x': x, 'c': c, 'positions': positions,
        'w_ada': nrm((L, D, 6 * D), 0.5 * D ** -0.5),
        'b_ada': nrm((L, 6 * D), 0.02),
        'norm1_g': gain((L, D)),
        'w_in': nrm((L, D, IN_COLS), D ** -0.5),
        'w_gate': nrm((L, D, 2 * D), D ** -0.5),
        'b_gate': nrm((L, 2 * D), 0.02),
        'q_norm_g': gain((L, DA_HEAD_DIM)),
        'k_norm_g': gain((L, DA_HEAD_DIM)),
        'lambda_q1': nrm((L, DA_HEAD_DIM), 0.1),
        'lambda_k1': nrm((L, DA_HEAD_DIM), 0.1),
        'lambda_q2': nrm((L, DA_HEAD_DIM), 0.1),
        'lambda_k2': nrm((L, DA_HEAD_DIM), 0.1),
        'subln_g': gain((L, 2 * DA_HEAD_DIM)),
        'rwkv_mu': jax.random.uniform(next(ks), (L, RWKV_COLS), f32),
        'w_decay0': jax.random.uniform(next(ks), (L, RWKV_WIDTH), f32, -4.0, -0.5),
        'w_decay2': nrm((L, DECAY_LORA, RWKV_WIDTH), 0.5 * DECAY_LORA ** -0.5),
        'a0': nrm((L, RWKV_WIDTH), 0.1),
        'a2': nrm((L, AAA_LORA, RWKV_WIDTH), 0.5 * AAA_LORA ** -0.5),
        'g2': nrm((L, GATE_LORA, RWKV_WIDTH), GATE_LORA ** -0.5),
        'k_k': 0.85 + nrm((L, RWKV_WIDTH), 0.02),
        'k_a': gain((L, RWKV_WIDTH)),
        'r_k': nrm((L, RWKV_HEADS, RWKV_HEAD), 0.1),
        'ln_x_w': gain((L, RWKV_WIDTH)),
        'ln_x_b': nrm((L, RWKV_WIDTH), 0.02),
        'w_branch_a': nrm((L, DA_WIDTH, D), DA_WIDTH ** -0.5),
        'w_branch_b': nrm((L, RWKV_WIDTH, D), RWKV_WIDTH ** -0.5),
        'w_out': nrm((L, D, D), D ** -0.5),
        'norm2_g': gain((L, D)),
        'w_router': nrm((L, D, E), D ** -0.5),
        'router_bias': nrm((L, E), 0.01),
        'w_expert_up_gate': nrm((L, E, D, 2 * F), D ** -0.5),
        'w_expert_down': nrm((L, E, F, D), F ** -0.5),
        'w_shared_up_gate': nrm((L, D, 2 * F), D ** -0.5),
        'w_shared_down': nrm((L, F, D), F ** -0.5),
    }


def reference(x, c, positions, w_ada, b_ada, norm1_g, w_in, w_gate, b_gate,
              q_norm_g, k_norm_g, lambda_q1, lambda_k1, lambda_q2, lambda_k2, subln_g,
              rwkv_mu, w_decay0, w_decay2, a0, a2, g2, k_k, k_a, r_k, ln_x_w, ln_x_b,
              w_branch_a, w_branch_b, w_out, norm2_g, w_router, router_bias,
              w_expert_up_gate, w_expert_down, w_shared_up_gate, w_shared_down):
    for l in range(DEPTH):
        x = hybrid_layer(x, c, positions, l, w_ada[l], b_ada[l], norm1_g[l], w_in[l], w_gate[l], b_gate[l],
                         q_norm_g[l], k_norm_g[l], lambda_q1[l], lambda_k1[l], lambda_q2[l], lambda_k2[l],
                         subln_g[l], rwkv_mu[l], w_decay0[l], w_decay2[l], a0[l], a2[l], g2[l], k_k[l],
                         k_a[l], r_k[l], ln_x_w[l], ln_x_b[l], w_branch_a[l], w_branch_b[l], w_out[l],
                         norm2_g[l], w_router[l], router_bias[l], w_expert_up_gate[l], w_expert_down[l],
                         w_shared_up_gate[l], w_shared_down[l])
    return x
```

```cpp
#define MK_ONE_LAUNCH 1
#include <hip/hip_runtime.h>
#include <cstdio>
#include <cstdint>
#include <cmath>

#define LAS __attribute__((address_space(3)))
#define GAS __attribute__((address_space(1)))
typedef unsigned short bf16_t;
typedef short bf16x8 __attribute__((ext_vector_type(8)));
typedef short s16x4 __attribute__((ext_vector_type(4)));
typedef float f32x2 __attribute__((ext_vector_type(2)));
typedef float f32x4 __attribute__((ext_vector_type(4)));
typedef float f32x16 __attribute__((ext_vector_type(16)));
typedef unsigned u32x2 __attribute__((ext_vector_type(2)));
typedef unsigned u32x4 __attribute__((ext_vector_type(4)));

__device__ __forceinline__ unsigned cvt_pk_bf16(float lo, float hi) { unsigned r; asm volatile("v_cvt_pk_bf16_f32 %0, %1, %2" : "=v"(r) : "v"(lo), "v"(hi)); return r; }
__device__ __forceinline__ float bf2f(unsigned h) { return __uint_as_float(h << 16); }
__device__ __forceinline__ unsigned f2bf(float f) { unsigned u = __builtin_bit_cast(unsigned, f); return (u + 0x7fffu + ((u >> 16) & 1u)) >> 16; }
__device__ __forceinline__ unsigned pk2(float lo, float hi) { return f2bf(lo) | (f2bf(hi) << 16); }
__device__ __forceinline__ float sigmoidf_(float x) { return 1.f / (1.f + __expf(-x)); }
__device__ __forceinline__ float wave_sum(float v) {
#pragma unroll
    for (int o = 1; o < 64; o <<= 1) v += __shfl_xor(v, o);
    return v;
}

namespace pg8 {
constexpr int BM = 256, BK = 64, HALF = 128, HTB = HALF * BK * 2  , STAGE_BYTES = 8 * HTB, NXCD = 8, WGM = 8;

__host__ __device__ __forceinline__ int lds_byte(int r, int c) { const int st = (r >> 4) * 2 + (c >> 5), rr = r & 15, cc = c & 31, ob = rr * 64 + cc * 2; return st * 1024 + (ob ^ (((ob >> 9) & 1) << 5)); }
__host__ __device__ __forceinline__ void stage_rc(int b, int& R, int& C) { const int st = b / 1024, sb = b % 1024, swz = sb ^ (((sb >> 9) & 1) << 5); R = (st >> 1) * 16 + swz / 64; C = (st & 1) * 32 + (swz % 64) / 2; }
__host__ __device__ __forceinline__ int perm32(int rho) { const int n = rho >> 4, i = rho & 15; return 8 * (i >> 2) + 4 * n + (i & 3); }

struct Unit { int pm, pn, aux; const char* a; const char* b; };

__device__ __forceinline__ void tile_map(int wgid, int nM, int nN, int& pm, int& pn) {
    const int nwg = nM * nN;
    { const int q = nwg / NXCD, r = nwg % NXCD, xcd = wgid % NXCD, off = wgid / NXCD; wgid = (xcd < r ? xcd * (q + 1) : r * (q + 1) + (xcd - r) * q) + off; }
    const int nig = WGM * nN, gid = wgid / nig, fm = gid * WGM, gsz = (nM - fm) < WGM ? (nM - fm) : WGM;
    pm = fm + ((wgid % nig) % gsz); pn = (wgid % nig) / gsz;
}
struct PlainOrder {
    const char* A; const char* Bt; int nM, nN, nwg, G, c; size_t tA, tB;
    __device__ __forceinline__ void init(const void* A_, const void* Bt_, int M, int N, int lda, int ldb, int G_, int c_) {
        A = (const char*)A_; Bt = (const char*)Bt_; nM = M / BM; nN = N / BM; nwg = nM * nN; G = G_; c = c_; tA = (size_t)BM * lda * 2; tB = (size_t)BM * ldb * 2; }
    __device__ __forceinline__ bool next(int i, Unit& u) const {
        const long L = (long)i * G + c; if (L >= nwg) return false;
        tile_map((int)L, nM, nN, u.pm, u.pn); u.aux = 0; u.a = A + (size_t)u.pm * tA; u.b = Bt + (size_t)u.pn * tB; return true; }
    __device__ __forceinline__ int srcrow(const Unit&, int r) const { return r; }
};

template <class Epi, class Sched, bool ALIGN_EPI, bool GATHER>
__device__ __forceinline__ void gemm_phase(LAS unsigned char* lds, const int K, const int lda, const int ldb, const Sched& S, const Epi& E) {
    const int tid = threadIdx.x, wid = __builtin_amdgcn_readfirstlane(tid >> 6), lane = tid & 63, wr = wid >> 2, wc = wid & 3, fr = lane & 15, fq = lane >> 4;
    const int nt = K / BK;
    unsigned voffA[2][2], voffAn[2][2], voffB[2]; int Rr[2], Cc[2];
#pragma unroll
    for (int i = 0; i < 2; ++i) { int R, C; stage_rc(tid * 16 + i * 8192, R, C); const int Rb = Epi::PERM ? ((R & ~31) + perm32(R & 31)) : R;
        Rr[i] = R; Cc[i] = C; voffB[i] = (unsigned)(Rb * ldb + C) * 2u;
        voffA[0][i] = (unsigned)(R * lda + C) * 2u; voffA[1][i] = (unsigned)((R + HALF) * lda + C) * 2u; voffAn[0][i] = voffA[0][i]; voffAn[1][i] = voffA[1][i]; }
    const size_t kstep = (size_t)(BK * 2);
    const size_t hstepB = (size_t)HALF * ldb * 2;
    const unsigned ldsw = (unsigned)wid * 1024u;
    const int aoff = lds_byte(wr * 64 + fr, fq * 8), boff = lds_byte(wc * 32 + fr, fq * 8);
#define PG8_SA(b, h) (((b) * 2 + (h)) * HTB)
#define PG8_SB(b, h) ((4 + (b) * 2 + (h)) * HTB)
#define PG8_STAGE(bufoff, gbase, voff) do { _Pragma("unroll") for (int _i = 0; _i < 2; ++_i) \
        __builtin_amdgcn_global_load_lds((const unsigned*)((const char*)(gbase) + (voff)[_i]), (LAS unsigned*)(lds + (bufoff) + ldsw + _i * 8192), 16, 0, 0); } while (0)
#define PG8_LDA(dst, b, h) do { _Pragma("unroll") for (int m = 0; m < 4; ++m) _Pragma("unroll") for (int k = 0; k < 2; ++k) dst[m][k] = *(const LAS bf16x8*)(lds + PG8_SA(b, h) + aoff + m * 2048 + k * 1024); } while (0)
#define PG8_LDB(dst, b, h) do { _Pragma("unroll") for (int n = 0; n < 2; ++n) _Pragma("unroll") for (int k = 0; k < 2; ++k) dst[n][k] = *(const LAS bf16x8*)(lds + PG8_SB(b, h) + boff + n * 2048 + k * 1024); } while (0)
#define PG8_MMA(ai, bj, At, Bt) do { __builtin_amdgcn_s_setprio(1); _Pragma("unroll") for (int m = 0; m < 4; ++m) _Pragma("unroll") for (int n = 0; n < 2; ++n) _Pragma("unroll") for (int k = 0; k < 2; ++k) \
        acc[ai][bj][m][n] = __builtin_amdgcn_mfma_f32_16x16x32_bf16(Bt[n][k], At[m][k], acc[ai][bj][m][n], 0, 0, 0); __builtin_amdgcn_s_setprio(0); } while (0)
#define PG8_WAIT_V(n) asm volatile("s_waitcnt vmcnt(" #n ")" ::: "memory")
#define PG8_WAIT_L(n) asm volatile("s_waitcnt lgkmcnt(" #n ")" ::: "memory")
#define PG8_BAR __builtin_amdgcn_s_barrier()
#define PG8_SCHED __builtin_amdgcn_sched_barrier(0)
#define PG8_GATHER(dst, u) do { _Pragma("unroll") for (int _h = 0; _h < 2; ++_h) _Pragma("unroll") for (int _i = 0; _i < 2; ++_i) \
        dst[_h][_i] = (unsigned)(S.srcrow(u, _h * HALF + Rr[_i]) * lda + Cc[_i]) * 2u; } while (0)
    Unit cur, nxt; int ui = 0;
    if (!S.next(0, cur)) return;
    f32x4 acc[2][2][4][2];
#pragma unroll
    for (int a = 0; a < 2; ++a)
#pragma unroll
        for (int b = 0; b < 2; ++b)
#pragma unroll
            for (int m = 0; m < 4; ++m)
#pragma unroll
                for (int n = 0; n < 2; ++n) acc[a][b][m][n] = (f32x4){0.f, 0.f, 0.f, 0.f};
    bf16x8 At[4][2], B0[2][2], B1[2][2];
    const char* cA = cur.a; const char* cB = cur.b;
    if constexpr (GATHER) { PG8_GATHER(voffA, cur); }
    PG8_STAGE(PG8_SB(0, 0), cB, voffB); PG8_STAGE(PG8_SB(0, 1), cB + hstepB, voffB); PG8_STAGE(PG8_SA(0, 0), cA, voffA[0]); PG8_STAGE(PG8_SA(0, 1), cA, voffA[1]);
    if (wr == 1) PG8_BAR;
    PG8_WAIT_V(2); PG8_BAR;
    PG8_STAGE(PG8_SB(1, 0), cB + kstep, voffB); PG8_STAGE(PG8_SA(1, 0), cA + kstep, voffA[0]); PG8_STAGE(PG8_SB(1, 1), cB + hstepB + kstep, voffB);
    PG8_WAIT_V(6); PG8_BAR;
    for (;;) {
        const bool has_next = S.next(ui + 1, nxt);
        const char* nA = has_next ? nxt.a : cA; const char* nB = has_next ? nxt.b : cB;
        if constexpr (GATHER) { if (has_next) { PG8_GATHER(voffAn, nxt); } else {
#pragma unroll
            for (int h = 0; h < 2; ++h)
#pragma unroll
                for (int i = 0; i < 2; ++i) voffAn[h][i] = voffA[h][i]; } }
#pragma nounroll
        for (int t = 0; t < nt; t += 2) {
            const bool last = (t == nt - 2);
            const char* a1 = cA + (size_t)(t + 1) * kstep;
            const char* a2 = last ? nA : cA + (size_t)(t + 2) * kstep; const char* b2 = last ? nB : cB + (size_t)(t + 2) * kstep;
            const char* a3 = a2 + kstep; const char* b3 = b2 + kstep;
            unsigned va[2][2];
#pragma unroll
            for (int h = 0; h < 2; ++h)
#pragma unroll
                for (int i = 0; i < 2; ++i) va[h][i] = (GATHER && last) ? voffAn[h][i] : voffA[h][i];
            PG8_LDB(B0, 0, 0); PG8_LDB(B1, 0, 1); PG8_SCHED; PG8_LDA(At, 0, 0); PG8_STAGE(PG8_SA(1, 1), a1, voffA[1]);
            PG8_WAIT_V(8); PG8_WAIT_L(0); PG8_BAR; PG8_MMA(0, 0, At, B0); PG8_MMA(0, 1, At, B1); PG8_BAR; PG8_SCHED;
            PG8_LDA(At, 0, 1); PG8_STAGE(PG8_SB(0, 0), b2, voffB); PG8_STAGE(PG8_SB(0, 1), b2 + hstepB, voffB); PG8_STAGE(PG8_SA(0, 0), a2, va[0]);
            PG8_WAIT_V(8); PG8_WAIT_L(0); PG8_BAR; PG8_MMA(1, 0, At, B0); PG8_MMA(1, 1, At, B1); PG8_BAR; PG8_SCHED;
            PG8_LDB(B0, 1, 0); PG8_LDB(B1, 1, 1); PG8_SCHED; PG8_LDA(At, 1, 0); PG8_STAGE(PG8_SA(0, 1), a2, va[1]);
            PG8_WAIT_V(8); PG8_WAIT_L(0); PG8_BAR; PG8_MMA(0, 0, At, B0); PG8_MMA(0, 1, At, B1); PG8_BAR; PG8_SCHED;
            PG8_LDA(At, 1, 1); PG8_STAGE(PG8_SB(1, 0), b3, voffB); PG8_STAGE(PG8_SB(1, 1), b3 + hstepB, voffB); PG8_STAGE(PG8_SA(1, 0), a3, va[0]);
            PG8_WAIT_V(8); PG8_WAIT_L(0); PG8_BAR; PG8_MMA(1, 0, At, B0); PG8_MMA(1, 1, At, B1); PG8_BAR; PG8_SCHED;
        }
        if constexpr (ALIGN_EPI) { if (wr == 0) PG8_BAR; }
        E(acc, cur, wr, wc, fr, fq);
        if (!has_next) break;
#pragma unroll
        for (int a = 0; a < 2; ++a)
#pragma unroll
            for (int b = 0; b < 2; ++b)
#pragma unroll
                for (int m = 0; m < 4; ++m)
#pragma unroll
                    for (int n = 0; n < 2; ++n) acc[a][b][m][n] = (f32x4){0.f, 0.f, 0.f, 0.f};
        cur = nxt; cA = nA; cB = nB; ++ui;
        if constexpr (GATHER) {
#pragma unroll
            for (int h = 0; h < 2; ++h)
#pragma unroll
                for (int i = 0; i < 2; ++i) voffA[h][i] = voffAn[h][i]; }
        if constexpr (ALIGN_EPI) { if (wr == 1) PG8_BAR; }
    }
    PG8_WAIT_V(0);
    if constexpr (!ALIGN_EPI) { if (wr == 0) PG8_BAR; }
    PG8_BAR;
#undef PG8_SA
#undef PG8_SB
#undef PG8_STAGE
#undef PG8_LDA
#undef PG8_LDB
#undef PG8_MMA
#undef PG8_WAIT_V
#undef PG8_WAIT_L
#undef PG8_BAR
#undef PG8_SCHED
#undef PG8_GATHER
}
}
#define RLX_AGENT __ATOMIC_RELAXED, __HIP_MEMORY_SCOPE_AGENT
#define LDS_WAIT() asm volatile("s_waitcnt lgkmcnt(0)" ::: "memory")
#define VM_WAIT() asm volatile("s_waitcnt vmcnt(0)" ::: "memory")
__device__ __forceinline__ unsigned long long rt() { return __builtin_amdgcn_s_memrealtime(); }

#define XB_TMO      128
#define XB_XCNT(j)  (256  + 64 * (j))
#define XB_XSUB(j)  (1280 + 64 * (j))
#define XB_XGEN(j)  (2304 + 64 * (j))
#define XB_TOP      3328
#define XB_TOPGEN   3392
#define XCD_BAR_WORDS 3456
#define XB_SPIN_CAP (1u << 18)

__device__ __forceinline__ unsigned xb_ld(unsigned* p)              { return __hip_atomic_load(p, __ATOMIC_RELAXED, __HIP_MEMORY_SCOPE_AGENT); }
__device__ __forceinline__ unsigned xb_add(unsigned* p, unsigned v) { return __hip_atomic_fetch_add(p, v, __ATOMIC_RELAXED, __HIP_MEMORY_SCOPE_AGENT); }
__device__ __forceinline__ unsigned xb_xcc_id() { return (unsigned)__builtin_amdgcn_s_getreg((3 << 11) | 20) & 0xFu; }
#define XB_SPIN(cond, bar) do { unsigned _sp = 0; while (cond) { __builtin_amdgcn_s_sleep(1); \
    if ((++_sp & 255u) == 0u) { if (xb_ld(&(bar)[XB_TMO])) break; if (_sp > XB_SPIN_CAP) { atomicAdd(&(bar)[XB_TMO], 1u); break; } } } } while (0)

struct XcdBarrier {
    unsigned* bar; unsigned x;
    volatile LAS unsigned* st;
};

__device__ __forceinline__ XcdBarrier xcd_barrier_post(unsigned* bar, volatile LAS unsigned* st) {
    XcdBarrier b; b.bar = bar; b.x = xb_xcc_id(); b.st = st;
    if (threadIdx.x == 0) (void)xb_add(&bar[XB_XCNT(b.x)], 1u);
    return b;
}
__device__ __forceinline__ void xcd_barrier_complete(unsigned* bar, unsigned x, unsigned& nloc, unsigned& nx) {
    const unsigned G = gridDim.x * gridDim.y * gridDim.z;
    unsigned sum, cnt, mine, sp = 0u;
    for (;;) {
        sum = 0u; cnt = 0u; mine = 0u;
#pragma unroll
        for (unsigned j = 0; j < 16; ++j) { const unsigned c = xb_ld(&bar[XB_XCNT(j)]); sum += c; cnt += (c > 0u) ? 1u : 0u; mine = (j == x) ? c : mine; }
        if (sum == G) break;
        __builtin_amdgcn_s_sleep(1);
        if ((++sp & 255u) == 0u) { if (xb_ld(&bar[XB_TMO])) break; if (sp > XB_SPIN_CAP) { atomicAdd(&bar[XB_TMO], 1u); break; } }
    }
    nloc = mine > 0u ? mine : 1u; nx = cnt > 0u ? cnt : 1u;
}

__device__ __forceinline__ void xcd_barrier(const XcdBarrier& b) {
    asm volatile("s_waitcnt vmcnt(0)" ::: "memory");
    __syncthreads();
    if (threadIdx.x == 0) {
        unsigned* bar = b.bar;
        __builtin_amdgcn_s_waitcnt(0);
        unsigned nloc = b.st[0], nx = b.st[1];
        if (nloc == 0u) { xcd_barrier_complete(bar, b.x, nloc, nx); b.st[0] = nloc; b.st[1] = nx; }
        const unsigned old = xb_add(&bar[XB_XSUB(b.x)], 1u);
        const unsigned gen = old / nloc;
        if (old + 1u == (gen + 1u) * nloc) {
            __builtin_amdgcn_fence(__ATOMIC_RELEASE, "agent");
            asm volatile("s_waitcnt vmcnt(0)" ::: "memory");
            const unsigned og = xb_add(&bar[XB_TOP], 1u);
            const unsigned tg = og / nx;
            if (og + 1u == (tg + 1u) * nx) xb_add(&bar[XB_TOPGEN], 1u);
            else XB_SPIN(xb_ld(&bar[XB_TOPGEN]) == tg, bar);
            __builtin_amdgcn_fence(__ATOMIC_ACQUIRE, "agent");
            xb_add(&bar[XB_XGEN(b.x)], 1u);
            asm volatile("s_waitcnt vmcnt(0)" ::: "memory");
        } else {
            XB_SPIN(xb_ld(&bar[XB_XGEN(b.x)]) == gen, bar);
            __builtin_amdgcn_fence(__ATOMIC_ACQUIRE, "agent");
            asm volatile("s_waitcnt vmcnt(0)" ::: "memory");
        }
    }
    __syncthreads();
}

constexpr int NB = 4, SEQ = 4096, D = 1024, M = NB * SEQ;
constexpr int N1 = 5376;
constexpr int NE = 256, FE = 256, CAP = 16384;
constexpr float QSCALE = 0.125f * 1.4426950408889634f;
constexpr int NPHASE = 14;
#ifndef MK_ONE_LAUNCH
#define MK_ONE_LAUNCH 0
#endif

constexpr size_t MiB = 1u << 20;
constexpr size_t WS_CTL = 0, CTL_ZERO_BYTES = 1 * MiB;
constexpr size_t WS_MODP = 1 * MiB;
constexpr size_t WS_MODF = 1 * MiB + 800 * 1024;
constexpr size_t WS_SCAL = 1 * MiB + 960 * 1024;
constexpr size_t WS_COS = 2 * MiB, WS_SIN = 4 * MiB;
constexpr size_t WS_W1T = 6 * MiB;
constexpr size_t WS_WAT = 17 * MiB, WS_WBT = 18 * MiB;
constexpr size_t WS_WOT = 19 * MiB;
constexpr size_t WS_WRT = 21 * MiB;
constexpr size_t WS_XN = 24 * MiB;
constexpr size_t WS_QN = 56 * MiB, WS_KN = 72 * MiB, WS_VB = 88 * MiB;
constexpr size_t WS_PRW = 104 * MiB;
constexpr size_t WS_GATE = 160 * MiB;
constexpr size_t WS_ACAT = 224 * MiB;
constexpr size_t WS_MIXF = 256 * MiB;
constexpr size_t WS_MIX = 320 * MiB;
constexpr size_t WS_X1 = 352 * MiB;
constexpr size_t WS_H2 = 416 * MiB;
constexpr size_t WS_LOGIT = 512 * MiB;
constexpr size_t WS_ROWMAP = 528 * MiB, WS_ROWW = 544 * MiB;
constexpr size_t WS_RW = 560 * MiB, RW_STRIDE = 32 * MiB;
constexpr size_t WS_WEU = 816 * MiB;
constexpr size_t WS_WED = 1074 * MiB;
constexpr size_t WS_HID = 1203 * MiB;
constexpr size_t WS_YS = 1308 * MiB;
constexpr size_t WS_END = 1596 * MiB;
constexpr int CW_BAR = 4096, CW_CNT = 8192;

constexpr int RING_BYTES = 131072;
constexpr int LDSCTL_OFF = RING_BYTES, MISC_OFF = LDSCTL_OFF + 320, MOE_OFF = LDSCTL_OFF + 1024;
constexpr int LDS_BYTES = 147456;

struct Params { const float* in[37]; float* out; unsigned char* ws; int ph_lo, ph_hi; };

__device__ __forceinline__ void tr_item(const float* W, int N, int k0, int n0, bf16_t* WT, int ldt, int drow0, int dcol0, int mode, LAS float* scr, int lane) {
#pragma unroll 8
    for (int i = 0; i < 32; ++i) { const int kk = 2 * i + (lane >> 5); float v = W[(size_t)(k0 + kk) * N + n0 + (lane & 31)]; if (mode) v = v - bf2f(f2bf(v)); scr[kk * 33 + (lane & 31)] = v; }
    LDS_WAIT(); asm volatile("" ::: "memory");
    const int c = lane & 7;
#pragma unroll
    for (int j = 0; j < 4; ++j) { const int n = (lane >> 3) + 8 * j; const LAS float* s = scr + (8 * c) * 33 + n;
        u32x4 o; o.x = pk2(s[0 * 33], s[1 * 33]); o.y = pk2(s[2 * 33], s[3 * 33]); o.z = pk2(s[4 * 33], s[5 * 33]); o.w = pk2(s[6 * 33], s[7 * 33]);
        *(u32x4*)(WT + (size_t)(drow0 + n) * ldt + dcol0 + 8 * c) = o; }
    LDS_WAIT(); asm volatile("" ::: "memory");
}
__device__ __forceinline__ int qkmap(int n0) { const int qk = n0 >> 9, r = n0 & 511, hd = r >> 6, bj = (r & 63) >> 5; return (qk * 2 + (hd >> 2)) * 256 + bj * 128 + (hd & 3) * 32; }
__device__ __forceinline__ int ugmap(int n0) { return n0 < 256 ? ((n0 >> 7) * 256 + (n0 & 127)) : ((((n0 - 256) >> 7) * 256) + 128 + ((n0 - 256) & 127)); }

__device__ __forceinline__ void phase_prologue(const Params& p, LAS unsigned char* lds, int G, int wave, int lane) {
    unsigned char* ws = p.ws;
    LAS float* scr = (LAS float*)(lds + wave * 16384);
    const int gw = blockIdx.x * 8 + wave, NGW = G * 8;
    constexpr int I_IN = 16 * 104, I_GATE = 16 * 64, I_BA = 8 * 32, I_OUT = 16 * 32, I_R = 16 * 8, I_EU = 257 * 256, I_ED = 257 * 128;
    constexpr int NITEMS = I_IN + I_GATE + 2 * I_BA + I_OUT + I_R + I_EU + I_ED;
    for (int it = gw; it < NITEMS; it += NGW) {
        int r = it;
        if (r < I_IN) { const int kb = r / 104, n0 = (r % 104) * 32; tr_item(p.in[6], 3328, kb * 64, n0, (bf16_t*)(ws + WS_W1T), 1024, n0 < 1024 ? qkmap(n0) : n0, kb * 64, 0, scr, lane); continue; } r -= I_IN;
        if (r < I_GATE) { const int kb = r / 64, n0 = (r % 64) * 32; tr_item(p.in[7], 2048, kb * 64, n0, (bf16_t*)(ws + WS_W1T), 1024, 3328 + n0, kb * 64, 0, scr, lane); continue; } r -= I_GATE;
        if (r < I_BA) { const int kb = r / 32, n0 = (r % 32) * 32; tr_item(p.in[27], 1024, kb * 64, n0, (bf16_t*)(ws + WS_WAT), 512, n0, kb * 64, 0, scr, lane); continue; } r -= I_BA;
        if (r < I_BA) { const int kb = r / 32, n0 = (r % 32) * 32; tr_item(p.in[28], 1024, kb * 64, n0, (bf16_t*)(ws + WS_WBT), 512, n0, kb * 64, 0, scr, lane); continue; } r -= I_BA;
        if (r < I_OUT) { const int kb = r / 32, n0 = (r % 32) * 32; tr_item(p.in[29], 1024, kb * 64, n0, (bf16_t*)(ws + WS_WOT), 1024, n0, kb * 64, 0, scr, lane); continue; } r -= I_OUT;
        if (r < I_R) { const int kb = r / 8, n0 = (r % 8) * 32;
            tr_item(p.in[31], 256, kb * 64, n0, (bf16_t*)(ws + WS_WRT), 3072, n0, kb * 64, 0, scr, lane);
            tr_item(p.in[31], 256, kb * 64, n0, (bf16_t*)(ws + WS_WRT), 3072, n0, 1024 + kb * 64, 0, scr, lane);
            tr_item(p.in[31], 256, kb * 64, n0, (bf16_t*)(ws + WS_WRT), 3072, n0, 2048 + kb * 64, 1, scr, lane); continue; } r -= I_R;
        if (r < I_EU) { const int e = r >> 8, rr = r & 255, kb = rr >> 4, n0 = (rr & 15) * 32;
            const float* W = e < 256 ? p.in[33] + (size_t)e * 1024 * 512 : p.in[35];
            tr_item(W, 512, kb * 64, n0, (bf16_t*)(ws + WS_WEU) + (size_t)e * 512 * 1024, 1024, ugmap(n0), kb * 64, 0, scr, lane); continue; } r -= I_EU;
        { const int e = r >> 7, rr = r & 127, kb = rr >> 5, n0 = (rr & 31) * 32;
            const float* W = e < 256 ? p.in[34] + (size_t)e * 256 * 1024 : p.in[36];
            tr_item(W, 1024, kb * 64, n0, (bf16_t*)(ws + WS_WED) + (size_t)e * 1024 * 256, 256, n0, kb * 64, 0, scr, lane); }
    }
    { const float* c = p.in[1]; const float* wa = p.in[3]; float* MODP = (float*)(ws + WS_MODP);
      for (int item = gw; item < 768; item += NGW) { const int ks = item / 96, n0 = (item % 96) * 64, k0 = ks * 128;
        float s0[4], s1[4], acc[4];
#pragma unroll
        for (int b = 0; b < 4; ++b) { const float a = c[b * 1024 + k0 + lane], a2 = c[b * 1024 + k0 + 64 + lane]; s0[b] = a * sigmoidf_(a); s1[b] = a2 * sigmoidf_(a2); acc[b] = 0.f; }
#pragma unroll 8
        for (int kk = 0; kk < 64; ++kk) { const float w = wa[(size_t)(k0 + kk) * 6144 + n0 + lane];
#pragma unroll
            for (int b = 0; b < 4; ++b) acc[b] += __shfl(s0[b], kk) * w; }
#pragma unroll 8
        for (int kk = 0; kk < 64; ++kk) { const float w = wa[(size_t)(k0 + 64 + kk) * 6144 + n0 + lane];
#pragma unroll
            for (int b = 0; b < 4; ++b) acc[b] += __shfl(s1[b], kk) * w; }
#pragma unroll
        for (int b = 0; b < 4; ++b) MODP[(ks * 4 + b) * 6144 + n0 + lane] = acc[b]; } }
    { const int* pos = (const int*)p.in[2]; float* ct = (float*)(ws + WS_COS); float* st = (float*)(ws + WS_SIN);
      const double INVF[32] = {1, 0.74989420933245587, 0.56234132519034907, 0.42169650342858228, 0.31622776601683794, 0.23713737056616555, 0.17782794100389226, 0.1333521432163324,
          0.10000000000000001, 0.074989420933245579, 0.056234132519034905, 0.042169650342858224, 0.031622776601683791, 0.02371373705661655, 0.017782794100389229, 0.013335214321633241,
          0.01, 0.0074989420933245588, 0.005623413251903491, 0.0042169650342858229, 0.003162277660168379, 0.0023713737056616549, 0.001778279410038923, 0.0013335214321633241,
          0.001, 0.00074989420933245575, 0.0005623413251903491, 0.00042169650342858229, 0.00031622776601683794, 0.00023713737056616554, 0.00017782794100389227, 0.0001333521432163324};
      for (int idx = gw * 64 + lane; idx < M * 32; idx += NGW * 64) { const int row = idx >> 5, i = idx & 31;
        double inv = 1.0;
#pragma unroll
        for (int j = 0; j < 32; ++j) inv = (i == j) ? INVF[j] : inv;
        const double rev = (double)pos[row] * inv * 0.15915494309189535; double fr = rev - floor(rev); if (fr > 0.5) fr -= 1.0;
        const float a = (float)(fr * 6.283185307179586);
        ct[idx] = __cosf(a); st[idx] = __sinf(a); } }
    if (gw == 0) { const float s1 = wave_sum(p.in[11][lane] * p.in[12][lane]), s2 = wave_sum(p.in[13][lane] * p.in[14][lane]);
        if (lane == 0) ((float*)(ws + WS_SCAL))[0] = expf(s1) - expf(s2) + 0.2f; }
}

__device__ __forceinline__ void norm_row(const float* xrow, const LAS float* mul, const LAS float* add, int lane, f32x4 (&y)[4]) {
    const f32x4* xr = (const f32x4*)xrow + lane; float s = 0.f;
#pragma unroll
    for (int j = 0; j < 4; ++j) { y[j] = xr[64 * j]; s += (y[j].x * y[j].x + y[j].y * y[j].y) + (y[j].z * y[j].z + y[j].w * y[j].w); }
    const float rstd = 1.f / sqrtf(wave_sum(s) * (1.f / D) + 1e-6f);
#pragma unroll
    for (int j = 0; j < 4; ++j) { const f32x4 mu = *(const LAS f32x4*)(mul + 4 * lane + 256 * j), ad = *(const LAS f32x4*)(add + 4 * lane + 256 * j); y[j] = y[j] * rstd * mu + ad; }
}
__device__ __forceinline__ void phase_norm1(const Params& p, LAS unsigned char* lds, int G, int tid, int wave, int lane) {
    unsigned char* ws = p.ws; const float* MODP = (const float*)(ws + WS_MODP); const float* bada = p.in[4]; float* MODF = (float*)(ws + WS_MODF);
    LAS float* mul = (LAS float*)lds; LAS float* add = mul + 1024;
    const int rows_per = M / G, r0 = blockIdx.x * rows_per, b = r0 / SEQ;
    for (int j = tid; j < 1024; j += 512) { float sh = bada[j], sc = bada[1024 + j];
#pragma unroll
        for (int ks = 0; ks < 8; ++ks) { sh += MODP[(ks * 4 + b) * 6144 + j]; sc += MODP[(ks * 4 + b) * 6144 + 1024 + j]; }
        mul[j] = p.in[5][j] * (1.f + sc); add[j] = sh; }
    for (int idx = blockIdx.x * 512 + tid; idx < 4 * 6144; idx += G * 512) { const int bb = idx / 6144, j = idx % 6144; float s = bada[j];
#pragma unroll
        for (int ks = 0; ks < 8; ++ks) s += MODP[(ks * 4 + bb) * 6144 + j];
        MODF[idx] = s; }
    __syncthreads();
    bf16_t* XN = (bf16_t*)(ws + WS_XN);
    for (int rr = wave; rr < rows_per; rr += 8) { const int row = r0 + rr; f32x4 y[4]; norm_row(p.in[0] + (size_t)row * D, mul, add, lane, y);
        unsigned long long* o8 = (unsigned long long*)(XN + (size_t)row * D) + lane;
#pragma unroll
        for (int j = 0; j < 4; ++j) o8[64 * j] = (unsigned long long)pk2(y[j].x, y[j].y) | ((unsigned long long)pk2(y[j].z, y[j].w) << 32); }
}
__device__ __forceinline__ void phase_norm2(const Params& p, LAS unsigned char* lds, int G, int tid, int wave, int lane) {
    unsigned char* ws = p.ws; const float* MODF = (const float*)(ws + WS_MODF);
    LAS float* mul = (LAS float*)lds; LAS float* add = mul + 1024;
    const int rows_per = M / G, r0 = blockIdx.x * rows_per, b = r0 / SEQ;
    for (int j = tid; j < 1024; j += 512) { mul[j] = p.in[30][j] * (1.f + MODF[b * 6144 + 4096 + j]); add[j] = MODF[b * 6144 + 3072 + j]; }
    __syncthreads();
    bf16_t* H2 = (bf16_t*)(ws + WS_H2); const float* X1 = (const float*)(ws + WS_X1);
    for (int rr = wave; rr < rows_per; rr += 8) { const int row = r0 + rr; f32x4 y[4]; norm_row(X1 + (size_t)row * D, mul, add, lane, y);
        unsigned long long* o8 = (unsigned long long*)(H2 + (size_t)row * 3072) + lane;
#pragma unroll
        for (int j = 0; j < 4; ++j) { const unsigned h0 = pk2(y[j].x, y[j].y), h1 = pk2(y[j].z, y[j].w);
            const unsigned l0 = pk2(y[j].x - bf2f(h0 & 0xffffu), y[j].y - bf2f(h0 >> 16)), l1 = pk2(y[j].z - bf2f(h1 & 0xffffu), y[j].w - bf2f(h1 >> 16));
            const unsigned long long hv = (unsigned long long)h0 | ((unsigned long long)h1 << 32), lv = (unsigned long long)l0 | ((unsigned long long)l1 << 32);
            o8[64 * j] = hv; o8[256 + 64 * j] = lv; o8[512 + 64 * j] = hv; } }
}

using pg8::Unit; using pg8::BM; using pg8::HALF;
__device__ __forceinline__ u32x4 pack8(const f32x4& a, const f32x4& b) { u32x4 w; w.x = cvt_pk_bf16(a[0], a[1]); w.y = cvt_pk_bf16(a[2], a[3]); w.z = cvt_pk_bf16(b[0], b[1]); w.w = cvt_pk_bf16(b[2], b[3]); return w; }
__device__ __forceinline__ void unpack8(const u32x4& w, f32x4& a, f32x4& b) { a = (f32x4){bf2f(w.x & 0xffffu), bf2f(w.x >> 16), bf2f(w.y & 0xffffu), bf2f(w.y >> 16)}; b = (f32x4){bf2f(w.z & 0xffffu), bf2f(w.z >> 16), bf2f(w.w & 0xffffu), bf2f(w.w >> 16)}; }

struct EpiG1 {
    static constexpr bool PERM = true;
    unsigned char* ws; const float *qg, *kg, *cosT, *sinT, *bgate;
    __device__ __forceinline__ void operator()(const f32x4 (&acc)[2][2][4][2], const Unit& u, int wr, int wc, int fr, int fq) const {
        const int row0 = u.pm * BM + wr * 64 + fr;
        if (u.pn < 4) {
            const bool isq = u.pn < 2; const float* g = isq ? qg : kg; bf16_t* O = (bf16_t*)(ws + (isq ? WS_QN : WS_KN)); const float osc = isq ? QSCALE : 1.f;
            const int hd = (u.pn & 1) * 4 + wc;
            f32x4 gv[2][2];
#pragma unroll
            for (int bj = 0; bj < 2; ++bj)
#pragma unroll
                for (int n = 0; n < 2; ++n) gv[bj][n] = *(const f32x4*)(g + 32 * bj + 8 * fq + 4 * n);
#pragma unroll
            for (int ai = 0; ai < 2; ++ai)
#pragma unroll
                for (int m = 0; m < 4; ++m) { const int row = row0 + ai * HALF + m * 16; float ss = 0.f;
#pragma unroll
                    for (int bj = 0; bj < 2; ++bj)
#pragma unroll
                        for (int n = 0; n < 2; ++n) { const f32x4 x = acc[ai][bj][m][n]; ss += (x[0] * x[0] + x[1] * x[1]) + (x[2] * x[2] + x[3] * x[3]); }
                    ss += __shfl_xor(ss, 16); ss += __shfl_xor(ss, 32);
                    const float rs = osc / sqrtf(ss * (1.f / 64.f) + 1e-6f);
                    f32x4 o1[2], o2[2];
#pragma unroll
                    for (int n = 0; n < 2; ++n) { const f32x4 c4 = *(const f32x4*)(cosT + (size_t)row * 32 + 8 * fq + 4 * n), s4 = *(const f32x4*)(sinT + (size_t)row * 32 + 8 * fq + 4 * n);
                        const f32x4 x1 = acc[ai][0][m][n] * gv[0][n] * rs, x2 = acc[ai][1][m][n] * gv[1][n] * rs;
                        o1[n] = x1 * c4 - x2 * s4; o2[n] = x2 * c4 + x1 * s4; }
                    bf16_t* dst = O + (size_t)row * 512 + hd * 64 + 8 * fq;
                    *(u32x4*)dst = pack8(o1[0], o1[1]); *(u32x4*)(dst + 32) = pack8(o2[0], o2[1]); }
        } else {
            int colt = u.pn * BM; size_t boff; int ld; bool gate = false;
            if (u.pn < 6) { boff = WS_VB; ld = 512; colt -= 1024; } else if (u.pn < 13) { boff = WS_PRW; ld = 1792; colt -= 1536; } else { boff = WS_GATE; ld = 2048; colt -= 3328; gate = true; }
            bf16_t* base = (bf16_t*)(ws + boff);
            const int col0 = colt + wc * 32 + 8 * fq;
            f32x4 bv[2][2];
#pragma unroll
            for (int bj = 0; bj < 2; ++bj)
#pragma unroll
                for (int n = 0; n < 2; ++n) bv[bj][n] = gate ? *(const f32x4*)(bgate + col0 + bj * HALF + 4 * n) : (f32x4){0.f, 0.f, 0.f, 0.f};
#pragma unroll
            for (int ai = 0; ai < 2; ++ai)
#pragma unroll
                for (int m = 0; m < 4; ++m) { bf16_t* rowp = base + (size_t)(row0 + ai * HALF + m * 16) * ld + col0;
#pragma unroll
                    for (int bj = 0; bj < 2; ++bj) { f32x4 v0 = acc[ai][bj][m][0] + bv[bj][0], v1 = acc[ai][bj][m][1] + bv[bj][1];
                        if (gate) {
#pragma unroll
                            for (int i = 0; i < 4; ++i) { v0[i] = sigmoidf_(v0[i]); v1[i] = sigmoidf_(v1[i]); } }
                        *(u32x4*)(rowp + bj * HALF) = pack8(v0, v1); } }
        }
    }
};

struct BranchOrder {
    const char *A, *Wa, *Wb; int G, c;
    __device__ __forceinline__ bool next(int i, Unit& u) const { const int tile = (i >> 1) * G + c; if (tile >= 256) return false;
        pg8::tile_map(tile, 64, 4, u.pm, u.pn); u.aux = i & 1; u.a = A + (size_t)u.pm * BM * 1024 * 2 + (u.aux ? 1024 : 0); u.b = (u.aux ? Wb : Wa) + (size_t)u.pn * BM * 512 * 2; return true; }
    __device__ __forceinline__ int srcrow(const Unit&, int r) const { return r; }
};
struct EpiBranch {
    static constexpr bool PERM = true;
    const bf16_t* GATE; float* MIXF; bf16_t* MIX;
    __device__ __forceinline__ void operator()(const f32x4 (&acc)[2][2][4][2], const Unit& u, int wr, int wc, int fr, int fq) const {
        const int row0 = u.pm * BM + wr * 64 + fr, col0 = u.pn * BM + wc * 32 + 8 * fq;
#pragma unroll
        for (int ai = 0; ai < 2; ++ai)
#pragma unroll
            for (int m = 0; m < 4; ++m) { const size_t row = (size_t)(row0 + ai * HALF + m * 16);
#pragma unroll
                for (int bj = 0; bj < 2; ++bj) { const int col = col0 + bj * HALF;
                    f32x4 g0, g1; unpack8(*(const u32x4*)(GATE + row * 2048 + (u.aux ? 1024 : 0) + col), g0, g1);
                    float* mf = MIXF + row * 1024 + col;
                    if (u.aux == 0) { *(f32x4*)mf = g0 * acc[ai][bj][m][0]; *(f32x4*)(mf + 4) = g1 * acc[ai][bj][m][1]; }
                    else { const f32x4 t0 = *(const f32x4*)mf + g0 * acc[ai][bj][m][0], t1 = *(const f32x4*)(mf + 4) + g1 * acc[ai][bj][m][1]; *(u32x4*)(MIX + row * 1024 + col) = pack8(t0, t1); } } }
    }
};
struct EpiOut {
    static constexpr bool PERM = true;
    const float* X; const float* MODF; float* X1;
    __device__ __forceinline__ void operator()(const f32x4 (&acc)[2][2][4][2], const Unit& u, int wr, int wc, int fr, int fq) const {
        const int row0 = u.pm * BM + wr * 64 + fr, col0 = u.pn * BM + wc * 32 + 8 * fq, b = (u.pm * BM) / SEQ;
        f32x4 gt[2][2];
#pragma unroll
        for (int bj = 0; bj < 2; ++bj)
#pragma unroll
            for (int n = 0; n < 2; ++n) gt[bj][n] = *(const f32x4*)(MODF + b * 6144 + 2048 + col0 + bj * HALF + 4 * n);
#pragma unroll
        for (int ai = 0; ai < 2; ++ai)
#pragma unroll
            for (int m = 0; m < 4; ++m) { const size_t off = (size_t)(row0 + ai * HALF + m * 16) * D + col0;
#pragma unroll
                for (int bj = 0; bj < 2; ++bj)
#pragma unroll
                    for (int n = 0; n < 2; ++n) { const size_t o = off + bj * HALF + 4 * n; *(f32x4*)(X1 + o) = *(const f32x4*)(X + o) + gt[bj][n] * acc[ai][bj][m][n]; } }
    }
};
struct EpiF32 {
    static constexpr bool PERM = true;
    float* O; int ldc;
    __device__ __forceinline__ void operator()(const f32x4 (&acc)[2][2][4][2], const Unit& u, int wr, int wc, int fr, int fq) const {
        const int row0 = u.pm * BM + wr * 64 + fr, col0 = u.pn * BM + wc * 32 + 8 * fq;
#pragma unroll
        for (int ai = 0; ai < 2; ++ai)
#pragma unroll
            for (int m = 0; m < 4; ++m) { float* rowp = O + (size_t)(row0 + ai * HALF + m * 16) * ldc + col0;
#pragma unroll
                for (int bj = 0; bj < 2; ++bj)
#pragma unroll
                    for (int n = 0; n < 2; ++n) *(f32x4*)(rowp + bj * HALF + 4 * n) = acc[ai][bj][m][n]; }
    }
};

__device__ __forceinline__ void moe_tables(const unsigned* CNT, LAS unsigned char* lds, int tid) {
    LAS int* pref = (LAS int*)(lds + MOE_OFF); LAS int* cntl = pref + 260;
    __syncthreads();
    if (tid < 257) cntl[tid] = tid < 256 ? (int)__hip_atomic_load((unsigned*)CNT + tid, RLX_AGENT) : M;
    __syncthreads();
    if (tid == 0) { int s = 0; for (int e = 0; e < 257; ++e) { pref[e] = s; s += (cntl[e] + 255) >> 8; } pref[257] = s; }
    __syncthreads();
}
__device__ __forceinline__ int moe_find(const LAS int* pref, int j) { int lo = 0, hi = 257; while (hi - lo > 1) { const int mid = (lo + hi) >> 1; if (pref[mid] <= j) lo = mid; else hi = mid; } return lo; }
struct MoeUpOrder {
    const LAS int* pref; const LAS int* cntl; const int* rowmap; const char* A; const char* W; int G, c;
    __device__ __forceinline__ bool next(int i, Unit& u) const { const int L = i * G + c; if (L >= pref[257] * 2) return false; const int j = L >> 1, e = moe_find(pref, j);
        u.pm = j - pref[e]; u.pn = L & 1; u.aux = e; u.a = A; u.b = W + (size_t)e * (512 * 1024 * 2) + (size_t)u.pn * (BM * 1024 * 2); return true; }
    __device__ __forceinline__ int srcrow(const Unit& u, int r) const { const int lr = u.pm * BM + r, e = u.aux; if (e == 256) return lr; const int n = cntl[e]; return rowmap[e * CAP + (lr < n ? lr : 0)] >> 4; }
};
struct EpiUp {
    static constexpr bool PERM = true;
    const LAS int* pref; bf16_t* HID;
    __device__ __forceinline__ void operator()(const f32x4 (&acc)[2][2][4][2], const Unit& u, int wr, int wc, int fr, int fq) const {
        const int hrow0 = (pref[u.aux] + u.pm) * BM + wr * 64 + fr, col0 = u.pn * HALF + wc * 32 + 8 * fq;
#pragma unroll
        for (int ai = 0; ai < 2; ++ai)
#pragma unroll
            for (int m = 0; m < 4; ++m) { f32x4 h[2];
#pragma unroll
                for (int n = 0; n < 2; ++n) { const f32x4 g = acc[ai][0][m][n], up = acc[ai][1][m][n];
#pragma unroll
                    for (int i = 0; i < 4; ++i) h[n][i] = g[i] * sigmoidf_(g[i]) * up[i]; }
                *(u32x4*)(HID + (size_t)(hrow0 + ai * HALF + m * 16) * FE + col0) = pack8(h[0], h[1]); }
    }
};
struct MoeDownOrder {
    const LAS int* pref; const char* A; const char* W; int G, c;
    __device__ __forceinline__ bool next(int i, Unit& u) const { const int L = i * G + c; if (L >= pref[257] * 4) return false; const int j = L >> 2, e = moe_find(pref, j);
        u.pm = j - pref[e]; u.pn = L & 3; u.aux = e; u.a = A + (size_t)j * (BM * FE * 2); u.b = W + (size_t)e * (1024 * 256 * 2) + (size_t)u.pn * (BM * FE * 2); return true; }
    __device__ __forceinline__ int srcrow(const Unit&, int r) const { return r; }
};
struct EpiDown {
    static constexpr bool PERM = true;
    const LAS int* cntl; const int* rowmap; const float* roww; bf16_t* YS;
    __device__ __forceinline__ void operator()(const f32x4 (&acc)[2][2][4][2], const Unit& u, int wr, int wc, int fr, int fq) const {
        const int e = u.aux, n = cntl[e], lr0 = u.pm * BM + wr * 64 + fr, col0 = u.pn * BM + wc * 32 + 8 * fq;
#pragma unroll
        for (int ai = 0; ai < 2; ++ai)
#pragma unroll
            for (int m = 0; m < 4; ++m) { const int lr = lr0 + ai * HALF + m * 16;
                if (lr < n) { int v; float w; if (e == 256) { v = lr * 16 + 8; w = 1.f; } else { v = rowmap[e * CAP + lr]; w = roww[e * CAP + lr]; }
                    bf16_t* dst = YS + ((size_t)(v >> 4) * 9 + (v & 15)) * 1024 + col0;
#pragma unroll
                    for (int bj = 0; bj < 2; ++bj) *(u32x4*)(dst + bj * HALF) = pack8(acc[ai][bj][m][0] * w, acc[ai][bj][m][1] * w); } }
    }
};

namespace att {
constexpr int LDS_K0 = 0, LDS_K1 = 8192, LDS_V = 16384, LDS_WS = 32768, LDS_X = 36864;
__device__ __forceinline__ int crow(int r, int hi) { return (r & 3) + 8 * (r >> 2) + 4 * hi; }
__device__ __forceinline__ void qkt(f32x16& p0, f32x16& p1, const LAS unsigned char* Kslot, const bf16x8* qr, int r32, int hi) {
    const LAS unsigned char* kb = Kslot + hi * 1024 + r32 * 16; const f32x16 z = {};
#pragma unroll
    for (int d0 = 0; d0 < 4; ++d0) { const bf16x8 b0 = *(const LAS bf16x8*)(kb + d0 * 2048), b1 = *(const LAS bf16x8*)(kb + d0 * 2048 + 512);
        if (d0 == 0) { p0 = __builtin_amdgcn_mfma_f32_32x32x16_bf16(b0, qr[0], z, 0, 0, 0); p1 = __builtin_amdgcn_mfma_f32_32x32x16_bf16(b1, qr[0], z, 0, 0, 0); }
        else { p0 = __builtin_amdgcn_mfma_f32_32x32x16_bf16(b0, qr[d0], p0, 0, 0, 0); p1 = __builtin_amdgcn_mfma_f32_32x32x16_bf16(b1, qr[d0], p1, 0, 0, 0); } }
}
__device__ __forceinline__ void pv4(f32x16* o, int vb, bf16x8 pa0, bf16x8 pa1, bf16x8 pa2, bf16x8 pa3) {
#pragma unroll
    for (int d0 = 0; d0 < 4; ++d0) { s16x4 lo[4], hi[4];
#pragma unroll
        for (int ks = 0; ks < 4; ++ks) {
            asm volatile("ds_read_b64_tr_b16 %0,%1 offset:%c2" : "=&v"(lo[ks]) : "v"(vb), "i"(d0 * 4096 + ks * 1024) : "memory");
            asm volatile("ds_read_b64_tr_b16 %0,%1 offset:%c2" : "=&v"(hi[ks]) : "v"(vb), "i"(d0 * 4096 + ks * 1024 + 512) : "memory"); }
        asm volatile("s_waitcnt lgkmcnt(0)" ::: "memory"); __builtin_amdgcn_sched_barrier(0);
#define PK(k) (bf16x8){lo[k][0], lo[k][1], lo[k][2], lo[k][3], hi[k][0], hi[k][1], hi[k][2], hi[k][3]}
        o[d0] = __builtin_amdgcn_mfma_f32_32x32x16_bf16(pa0, PK(0), o[d0], 0, 0, 0);
        o[d0] = __builtin_amdgcn_mfma_f32_32x32x16_bf16(pa1, PK(1), o[d0], 0, 0, 0);
        o[d0] = __builtin_amdgcn_mfma_f32_32x32x16_bf16(pa2, PK(2), o[d0], 0, 0, 0);
        o[d0] = __builtin_amdgcn_mfma_f32_32x32x16_bf16(pa3, PK(3), o[d0], 0, 0, 0);
#undef PK
    }
}
__device__ __forceinline__ void attn_unit(int b, int h, int qb, const bf16_t* Qn, const bf16_t* Kn, const bf16_t* Vb, bf16_t* ACAT, const float* subg, float lam, LAS unsigned char* lds) {
    const int tid = threadIdx.x, lane = tid & 63, r32 = lane & 31, hi = lane >> 5; const int wid = __builtin_amdgcn_readfirstlane(tid >> 6), st = wid >> 2, wq = wid & 3;
    const long rowbase = (long)b * SEQ; const int q0 = qb * 128;
    const bf16_t* Qw = Qn + (rowbase + q0 + 32 * wq) * 512 + (2 * h + st) * 64;
    bf16x8 qr[4];
#pragma unroll
    for (int d0 = 0; d0 < 4; ++d0) qr[d0] = *(const bf16x8*)(Qw + (long)r32 * 512 + d0 * 16 + hi * 8);
    const int ntw = (q0 + 32 * wq) / 64 + 1, NT = q0 / 64 + 2;
    float m_run = -1e30f, l_run = 0.f; f32x16 o[4];
#pragma unroll
    for (int d0 = 0; d0 < 4; ++d0) o[d0] = f32x16{};
    LAS float* wsf = (LAS float*)(lds + LDS_WS) + wid * 128;
    const LAS unsigned char* Ks = lds + (st ? LDS_K1 : LDS_K0);
    const int vb0 = (int)(unsigned)(uintptr_t)(lds + LDS_V) + ((lane >> 4) & 1) * 32 + (lane & 3) * 8 + (4 * hi + ((lane & 15) >> 2)) * 64;
    for (int t = 0; t < NT; ++t) {
        __syncthreads();
        { const int c8 = tid >> 6, kv = tid & 63; const bf16_t* kr = Kn + (rowbase + 64 * t + kv) * 512 + (2 * h) * 64 + c8 * 8;
          const u32x4 k0v = *(const u32x4*)kr, k1v = *(const u32x4*)(kr + 64);
          *(LAS u32x4*)(lds + LDS_K0 + c8 * 1024 + kv * 16) = k0v; *(LAS u32x4*)(lds + LDS_K1 + c8 * 1024 + kv * 16) = k1v;
#pragma unroll
          for (int j = 0; j < 2; ++j) { const int pidx = tid + 512 * j, ch = pidx & 3, key = (pidx >> 2) & 15, kg = (pidx >> 6) & 3, dblk = pidx >> 8;
              const u32x4 vv = *(const u32x4*)(Vb + (rowbase + 64 * t + kg * 16 + key) * 512 + h * 128 + dblk * 32 + ch * 8); *(LAS u32x4*)(lds + LDS_V + pidx * 16) = vv; } }
        __syncthreads();
        if (t < ntw) {
            f32x16 p0, p1; qkt(p0, p1, Ks, qr, r32, hi);
            float rm = p0[0];
#pragma unroll
            for (int r = 0; r < 16; ++r) { rm = fmaxf(rm, p0[r]); rm = fmaxf(rm, p1[r]); }
            rm = fmaxf(rm, __shfl_xor(rm, 32));
            const float mnew = fmaxf(m_run, rm), alpha = __builtin_amdgcn_exp2f(m_run - mnew); m_run = mnew;
            float s = 0.f;
#pragma unroll
            for (int r = 0; r < 16; ++r) { p0[r] = __builtin_amdgcn_exp2f(p0[r] - mnew); p1[r] = __builtin_amdgcn_exp2f(p1[r] - mnew); s += p0[r] + p1[r]; }
            s += __shfl_xor(s, 32); l_run = l_run * alpha + s;
            if (hi == 0) wsf[r32] = alpha;
            LDS_WAIT();
#pragma unroll
            for (int r = 0; r < 16; ++r) { const float f = wsf[crow(r, hi)];
#pragma unroll
                for (int d0 = 0; d0 < 4; ++d0) o[d0][r] *= f; }
            u32x4 pw0, pw1, pw2, pw3;
#define PKW(P, B) cvt_pk_bf16(P[B], P[B + 1])
            pw0 = (u32x4){PKW(p0, 0), PKW(p0, 2), PKW(p0, 4), PKW(p0, 6)}; pw1 = (u32x4){PKW(p0, 8), PKW(p0, 10), PKW(p0, 12), PKW(p0, 14)};
            pw2 = (u32x4){PKW(p1, 0), PKW(p1, 2), PKW(p1, 4), PKW(p1, 6)}; pw3 = (u32x4){PKW(p1, 8), PKW(p1, 10), PKW(p1, 12), PKW(p1, 14)};
#undef PKW
            pv4(o, vb0, __builtin_bit_cast(bf16x8, pw0), __builtin_bit_cast(bf16x8, pw1), __builtin_bit_cast(bf16x8, pw2), __builtin_bit_cast(bf16x8, pw3));
        }
    }
    if (hi == 0) wsf[32 + r32] = l_run;
    LDS_WAIT();
    float rli[16];
#pragma unroll
    for (int r = 0; r < 16; ++r) rli[r] = 1.f / wsf[32 + crow(r, hi)];
    LAS float* X = (LAS float*)(lds + LDS_X) + wq * (32 * 128);
    if (st == 1) {
#pragma unroll
        for (int d0 = 0; d0 < 4; ++d0)
#pragma unroll
            for (int r = 0; r < 16; ++r) X[crow(r, hi) * 128 + d0 * 32 + r32] = o[d0][r] * rli[r];
    }
    __syncthreads();
    if (st == 0) {
        float ss[16];
#pragma unroll
        for (int r = 0; r < 16; ++r) ss[r] = 0.f;
#pragma unroll
        for (int d0 = 0; d0 < 4; ++d0)
#pragma unroll
            for (int r = 0; r < 16; ++r) { const float v = o[d0][r] * rli[r] - lam * X[crow(r, hi) * 128 + d0 * 32 + r32]; o[d0][r] = v; ss[r] += v * v; }
#pragma unroll
        for (int r = 0; r < 16; ++r) {
#pragma unroll
            for (int off = 1; off < 32; off <<= 1) ss[r] += __shfl_xor(ss[r], off);
            ss[r] = 0.8f / sqrtf(ss[r] * (1.f / 128.f) + 1e-5f); }
#pragma unroll
        for (int d0 = 0; d0 < 4; ++d0) { const float g = subg[d0 * 32 + r32];
#pragma unroll
            for (int r = 0; r < 16; ++r) ACAT[(size_t)(rowbase + q0 + 32 * wq + crow(r, hi)) * 1024 + h * 128 + d0 * 32 + r32] = (bf16_t)f2bf(o[d0][r] * ss[r] * g); }
    }
}
}

__device__ __forceinline__ float tshift(const bf16_t* PRW, int row, int col, float mu) {
    const float pv = bf2f(PRW[(size_t)row * 1792 + col]); const float pp = (row % SEQ) == 0 ? 0.f : bf2f(PRW[(size_t)(row - 1) * 1792 + col]); return pv + (pp - pv) * mu; }
__device__ __forceinline__ void rwkv_prep_unit(const Params& p, int unit, LAS unsigned char* lds, int tid) {
    unsigned char* ws = p.ws; const bf16_t* PRW = (const bf16_t*)(ws + WS_PRW); const float* mu = p.in[16];
    LAS float* lw = (LAS float*)lds; LAS float* la = lw + 32 * 64; LAS float* lg = la + 32 * 64;
    const int t0 = unit * 32;
    __syncthreads();
    for (int idx = tid; idx < 32 * 256; idx += 512) { const int t = idx >> 8, cc = idx & 255, col = 1536 + cc; const float xs = tshift(PRW, t0 + t, col, mu[col]);
        if (cc < 64) lw[t * 64 + cc] = tanhf(xs); else if (cc < 128) la[t * 64 + cc - 64] = xs; else lg[t * 128 + cc - 128] = sigmoidf_(xs); }
    __syncthreads();
    const int c = tid; float acc[32];
    float* R = (float*)(ws + WS_RW); float* Kp = (float*)(ws + WS_RW + RW_STRIDE); float* V = (float*)(ws + WS_RW + 2 * RW_STRIDE); float* KK = (float*)(ws + WS_RW + 3 * RW_STRIDE);
    float* BB = (float*)(ws + WS_RW + 4 * RW_STRIDE); float* DD = (float*)(ws + WS_RW + 5 * RW_STRIDE); float* GG = (float*)(ws + WS_RW + 6 * RW_STRIDE);
#pragma unroll
    for (int t = 0; t < 32; ++t) acc[t] = 0.f;
    for (int k = 0; k < 64; k += 4) { const float w0 = p.in[18][(k + 0) * 512 + c], w1 = p.in[18][(k + 1) * 512 + c], w2 = p.in[18][(k + 2) * 512 + c], w3 = p.in[18][(k + 3) * 512 + c];
#pragma unroll
        for (int t = 0; t < 32; ++t) { const f32x4 l4 = *(const LAS f32x4*)(lw + t * 64 + k); acc[t] += (l4.x * w0 + l4.y * w1) + (l4.z * w2 + l4.w * w3); } }
    { const float wd0 = p.in[17][c];
#pragma unroll
      for (int t = 0; t < 32; ++t) { const float u = -(wd0 + acc[t]); const float sp = u > 20.f ? u : log1pf(expf(u)); const float w = -sp - 0.5f; DD[(size_t)(t0 + t) * 512 + c] = expf(-expf(w)); } }
#pragma unroll
    for (int t = 0; t < 32; ++t) acc[t] = 0.f;
    for (int k = 0; k < 64; k += 4) { const float w0 = p.in[20][(k + 0) * 512 + c], w1 = p.in[20][(k + 1) * 512 + c], w2 = p.in[20][(k + 2) * 512 + c], w3 = p.in[20][(k + 3) * 512 + c];
#pragma unroll
        for (int t = 0; t < 32; ++t) { const f32x4 l4 = *(const LAS f32x4*)(la + t * 64 + k); acc[t] += (l4.x * w0 + l4.y * w1) + (l4.z * w2 + l4.w * w3); } }
    { const float a0 = p.in[19][c], kkc = p.in[22][c], kac = p.in[23][c], mur = mu[c], muk = mu[512 + c], muv = mu[1024 + c];
#pragma unroll 4
      for (int t = 0; t < 32; ++t) { const int row = t0 + t; const float av = sigmoidf_(a0 + acc[t]);
        const float xr = tshift(PRW, row, c, mur), xk = tshift(PRW, row, 512 + c, muk), xv = tshift(PRW, row, 1024 + c, muv);
        const float kkv = xk * kkc; const float ss = wave_sum(kkv * kkv); const float kkn = kkv / fmaxf(sqrtf(ss), 1e-12f);
        const size_t o = (size_t)row * 512 + c; R[o] = xr; Kp[o] = xk * (1.f + (av - 1.f) * kac); V[o] = xv; KK[o] = kkn; BB[o] = kkn * av; } }
#pragma unroll
    for (int t = 0; t < 32; ++t) acc[t] = 0.f;
    for (int k = 0; k < 128; k += 4) { const float w0 = p.in[21][(k + 0) * 512 + c], w1 = p.in[21][(k + 1) * 512 + c], w2 = p.in[21][(k + 2) * 512 + c], w3 = p.in[21][(k + 3) * 512 + c];
#pragma unroll
        for (int t = 0; t < 32; ++t) { const f32x4 l4 = *(const LAS f32x4*)(lg + t * 128 + k); acc[t] += (l4.x * w0 + l4.y * w1) + (l4.z * w2 + l4.w * w3); } }
#pragma unroll
    for (int t = 0; t < 32; ++t) GG[(size_t)(t0 + t) * 512 + c] = acc[t];
}
__device__ __forceinline__ void rwkv_scan_v1(const Params& p, LAS unsigned char* lds, int tid, int wave, int lane) {
    unsigned char* ws = p.ws; if (blockIdx.x >= 16) return;
    const float* R = (const float*)(ws + WS_RW); const float* Kp = (const float*)(ws + WS_RW + RW_STRIDE); const float* V = (const float*)(ws + WS_RW + 2 * RW_STRIDE); const float* KK = (const float*)(ws + WS_RW + 3 * RW_STRIDE);
    const float* BB = (const float*)(ws + WS_RW + 4 * RW_STRIDE); const float* DD = (const float*)(ws + WS_RW + 5 * RW_STRIDE); float* Y = (float*)(ws + WS_RW + 7 * RW_STRIDE);
    const int half = wave >> 2, bh = blockIdx.x * 2 + half, b = bh >> 3, h = bh & 7, t256 = tid & 255;
    LAS float* base = (LAS float*)lds + half * (7 * 2048);
    LAS float* sR = base; LAS float* sD = base + 2048; LAS float* sK = base + 4096; LAS float* sKK = base + 6144; LAS float* sB = base + 8192; LAS float* sV = base + 10240; LAS float* sY = base + 12288;
    const int vrow = 16 * (wave & 3) + (lane >> 2), kq = lane & 3;
    float S[16];
#pragma unroll
    for (int j = 0; j < 16; ++j) S[j] = 0.f;
    for (int ch = 0; ch < SEQ / 32; ++ch) {
        for (int idx = t256; idx < 2048; idx += 256) { const int t = idx >> 6, j = idx & 63; const size_t off = (size_t)(b * SEQ + ch * 32 + t) * 512 + h * 64 + j;
            sR[idx] = R[off]; sD[idx] = DD[off]; sK[idx] = Kp[off]; sKK[idx] = KK[off]; sB[idx] = BB[off]; sV[idx] = V[off]; }
        __syncthreads();
        for (int t = 0; t < 32; ++t) {
            float kk[16], dv[16], bv[16], kv[16], rv[16];
#pragma unroll
            for (int q = 0; q < 4; ++q) { const f32x4 a = *(const LAS f32x4*)(sKK + t * 64 + 16 * kq + 4 * q), d4 = *(const LAS f32x4*)(sD + t * 64 + 16 * kq + 4 * q), b4 = *(const LAS f32x4*)(sB + t * 64 + 16 * kq + 4 * q),
                    k4 = *(const LAS f32x4*)(sK + t * 64 + 16 * kq + 4 * q), r4 = *(const LAS f32x4*)(sR + t * 64 + 16 * kq + 4 * q);
#pragma unroll
                for (int i = 0; i < 4; ++i) { kk[4 * q + i] = a[i]; dv[4 * q + i] = d4[i]; bv[4 * q + i] = b4[i]; kv[4 * q + i] = k4[i]; rv[4 * q + i] = r4[i]; } }
            float sa = 0.f;
#pragma unroll
            for (int j = 0; j < 16; ++j) sa -= S[j] * kk[j];
            sa += __shfl_xor(sa, 1); sa += __shfl_xor(sa, 2);
            const float vv = sV[t * 64 + vrow]; float y = 0.f;
#pragma unroll
            for (int j = 0; j < 16; ++j) { S[j] = S[j] * dv[j] + sa * bv[j] + vv * kv[j]; y += S[j] * rv[j]; }
            y += __shfl_xor(y, 1); y += __shfl_xor(y, 2);
            if (kq == 0) sY[t * 64 + vrow] = y;
        }
        __syncthreads();
        for (int idx = t256; idx < 2048; idx += 256) { const int t = idx >> 6, j = idx & 63; Y[(size_t)(b * SEQ + ch * 32 + t) * 512 + h * 64 + j] = sY[idx]; }
    }
}
__device__ __forceinline__ void rwkv_post(const Params& p, int G, int wave, int lane) {
    unsigned char* ws = p.ws; const float* R = (const float*)(ws + WS_RW); const float* Kp = (const float*)(ws + WS_RW + RW_STRIDE); const float* V = (const float*)(ws + WS_RW + 2 * RW_STRIDE);
    const float* GG = (const float*)(ws + WS_RW + 6 * RW_STRIDE); const float* Y = (const float*)(ws + WS_RW + 7 * RW_STRIDE); bf16_t* ACAT = (bf16_t*)(ws + WS_ACAT);
    const int c = wave * 64 + lane; const float lw = p.in[25][c], lb = p.in[26][c], rk = p.in[24][c];
    for (int row = blockIdx.x; row < M; row += G) { const size_t o = (size_t)row * 512 + c; const float y = Y[o];
        const float mean = wave_sum(y) * (1.f / 64.f); const float dy = y - mean; const float var = wave_sum(dy * dy) * (1.f / 64.f);
        const float yn = dy / sqrtf(var + 64e-5f) * lw + lb; const float bonus = wave_sum(R[o] * Kp[o] * rk) * V[o];
        ACAT[(size_t)row * 1024 + 512 + c] = (bf16_t)f2bf((yn + bonus) * GG[o]); }
}

__device__ __forceinline__ void phase_topk(const Params& p, int G, int wave, int lane) {
    unsigned char* ws = p.ws; const float* LOGIT = (const float*)(ws + WS_LOGIT); const float* rb = p.in[32];
    unsigned* CNT = (unsigned*)(ws + WS_CTL) + CW_CNT; int* ROWMAP = (int*)(ws + WS_ROWMAP); float* ROWW = (float*)(ws + WS_ROWW);
    const float NEG = -INFINITY; const f32x4 rb4 = *(const f32x4*)(rb + 4 * lane);
    for (int row = blockIdx.x * 8 + wave; row < M; row += G * 8) {
        const f32x4 l4 = *(const f32x4*)(LOGIT + (size_t)row * 256 + 4 * lane);
        float sc[4], cand[4];
#pragma unroll
        for (int j = 0; j < 4; ++j) { sc[j] = sigmoidf_(l4[j]); cand[j] = sc[j] + rb4[j]; }
        float m1, m2; { const float a = fmaxf(cand[0], cand[1]), c2 = fminf(cand[0], cand[1]), d = fmaxf(cand[2], cand[3]), e2 = fminf(cand[2], cand[3]); m1 = fmaxf(a, d); m2 = fmaxf(fminf(a, d), fmaxf(c2, e2)); }
#pragma unroll
        for (int off = 1; off < 8; off <<= 1) { const float o1 = __shfl_xor(m1, off), o2 = __shfl_xor(m2, off); const float n1 = fmaxf(m1, o1), n2 = fmaxf(fminf(m1, o1), fmaxf(m2, o2)); m1 = n1; m2 = n2; }
        const float gs = m1 + m2; const int g = lane >> 3; int rank = 0;
#pragma unroll
        for (int gg = 0; gg < 8; ++gg) { const float og = __shfl(gs, gg * 8); rank += (og > gs || (og == gs && gg < g)) ? 1 : 0; }
        if (rank >= 4) {
#pragma unroll
            for (int j = 0; j < 4; ++j) cand[j] = NEG; }
        int myE = 0; float myS = 0.f, ssum = 0.f;
#pragma unroll
        for (int k = 0; k < 8; ++k) {
            float bv = cand[0]; int bi = 4 * lane;
#pragma unroll
            for (int j = 1; j < 4; ++j) if (cand[j] > bv) { bv = cand[j]; bi = 4 * lane + j; }
#pragma unroll
            for (int off = 1; off < 64; off <<= 1) { const float ov = __shfl_xor(bv, off); const int oi = __shfl_xor(bi, off); if (ov > bv || (ov == bv && oi < bi)) { bv = ov; bi = oi; } }
            const int owner = bi >> 2, jj = bi & 3;
            const float mine = jj == 0 ? sc[0] : jj == 1 ? sc[1] : jj == 2 ? sc[2] : sc[3];
            const float sk = __shfl(mine, owner);
            if (lane == owner) {
#pragma unroll
                for (int j = 0; j < 4; ++j) if (j == jj) cand[j] = NEG; }
            ssum += sk; if (lane == k) { myE = bi; myS = sk; }
        }
        if (lane < 8) { const float w = myS / ssum * 2.5f; const unsigned pos = __hip_atomic_fetch_add(CNT + myE, 1u, RLX_AGENT);
            ROWMAP[myE * CAP + pos] = row * 16 + lane; ROWW[myE * CAP + pos] = w; }
    }
}
__device__ __forceinline__ void phase_combine(const Params& p, int G, int tid) {
    unsigned char* ws = p.ws; const float* X1 = (const float*)(ws + WS_X1); const float* MODF = (const float*)(ws + WS_MODF); const bf16_t* YS = (const bf16_t*)(ws + WS_YS);
    for (int idx = blockIdx.x * 512 + tid; idx < M * 128; idx += G * 512) { const int row = idx >> 7, col = (idx & 127) * 8, b = row / SEQ;
        f32x4 a0 = {0.f, 0.f, 0.f, 0.f}, a1 = {0.f, 0.f, 0.f, 0.f};
#pragma unroll
        for (int s = 0; s < 9; ++s) { f32x4 t0, t1; unpack8(*(const u32x4*)(YS + ((size_t)row * 9 + s) * 1024 + col), t0, t1); a0 += t0; a1 += t1; }
        const f32x4 g0 = *(const f32x4*)(MODF + b * 6144 + 5120 + col), g1 = *(const f32x4*)(MODF + b * 6144 + 5120 + col + 4);
        const size_t o = (size_t)row * D + col;
        *(f32x4*)(p.out + o) = *(const f32x4*)(X1 + o) + g0 * a0; *(f32x4*)(p.out + o + 4) = *(const f32x4*)(X1 + o + 4) + g1 * a1; }
}

__global__ void __launch_bounds__(512, 2) hybrid_fwd(Params p) {
    extern __shared__ __attribute__((aligned(16))) unsigned char lds_raw[];
    LAS unsigned char* lds = (LAS unsigned char*)lds_raw;
    const int tid = threadIdx.x, lane = tid & 63, wave = __builtin_amdgcn_readfirstlane(tid >> 6), G = gridDim.x;
    unsigned char* ws = p.ws; unsigned* ctl = (unsigned*)(ws + WS_CTL);
    for (int u = tid; u < (LDS_BYTES - LDSCTL_OFF) / 4; u += 512) ((LAS unsigned*)(lds + LDSCTL_OFF))[u] = 0u;
    __syncthreads();
    XcdBarrier bar; bar.bar = ctl + CW_BAR; bar.x = 0; bar.st = nullptr;
    if (MK_ONE_LAUNCH) bar = xcd_barrier_post(ctl + CW_BAR, (volatile LAS unsigned*)(lds + MISC_OFF) + 8);
    const int lo = p.ph_lo, hi = p.ph_hi;
#define IN(k) (lo <= (k) && (k) < hi)
#define SEAM(k) do { if (MK_ONE_LAUNCH && IN(k) && IN((k) + 1)) xcd_barrier(bar); } while (0)

    if (IN(0)) { phase_prologue(p, lds, G, wave, lane); } SEAM(0);
    if (IN(1)) { phase_norm1(p, lds, G, tid, wave, lane); } SEAM(1);
    if (IN(2)) {
        pg8::PlainOrder S; S.init(ws + WS_XN, ws + WS_W1T, M, N1, 1024, 1024, G, (int)blockIdx.x);
        EpiG1 E{ws, p.in[9], p.in[10], (const float*)(ws + WS_COS), (const float*)(ws + WS_SIN), p.in[8]};
        pg8::gemm_phase<EpiG1, pg8::PlainOrder, true, false>(lds, 1024, 1024, 1024, S, E);
    } SEAM(2);
    if (IN(3)) {
        const float lam = ((const float*)(ws + WS_SCAL))[0];
        for (int pi = blockIdx.x; pi < 256; pi += G) { const int bh = pi >> 4, s = pi & 15;
            att::attn_unit(bh >> 2, bh & 3, s, (const bf16_t*)(ws + WS_QN), (const bf16_t*)(ws + WS_KN), (const bf16_t*)(ws + WS_VB), (bf16_t*)(ws + WS_ACAT), p.in[15], lam, lds);
            att::attn_unit(bh >> 2, bh & 3, 31 - s, (const bf16_t*)(ws + WS_QN), (const bf16_t*)(ws + WS_KN), (const bf16_t*)(ws + WS_VB), (bf16_t*)(ws + WS_ACAT), p.in[15], lam, lds); }
        for (int un = blockIdx.x; un < M / 32; un += G) rwkv_prep_unit(p, un, lds, tid);
    } SEAM(3);
    if (IN(4)) { rwkv_scan_v1(p, lds, tid, wave, lane); } SEAM(4);
    if (IN(5)) { rwkv_post(p, G, wave, lane); } SEAM(5);
    if (IN(6)) {
        BranchOrder S{(const char*)(ws + WS_ACAT), (const char*)(ws + WS_WAT), (const char*)(ws + WS_WBT), G, (int)blockIdx.x};
        EpiBranch E{(const bf16_t*)(ws + WS_GATE), (float*)(ws + WS_MIXF), (bf16_t*)(ws + WS_MIX)};
        pg8::gemm_phase<EpiBranch, BranchOrder, true, false>(lds, 512, 1024, 512, S, E);
    } SEAM(6);
    if (IN(7)) {
        pg8::PlainOrder S; S.init(ws + WS_MIX, ws + WS_WOT, M, 1024, 1024, 1024, G, (int)blockIdx.x);
        EpiOut E{p.in[0], (const float*)(ws + WS_MODF), (float*)(ws + WS_X1)};
        pg8::gemm_phase<EpiOut, pg8::PlainOrder, true, false>(lds, 1024, 1024, 1024, S, E);
    } SEAM(7);
    if (IN(8)) { phase_norm2(p, lds, G, tid, wave, lane); } SEAM(8);
    if (IN(9)) {
        pg8::PlainOrder S; S.init(ws + WS_H2, ws + WS_WRT, M, 256, 3072, 3072, G, (int)blockIdx.x);
        EpiF32 E{(float*)(ws + WS_LOGIT), 256};
        pg8::gemm_phase<EpiF32, pg8::PlainOrder, true, false>(lds, 3072, 3072, 3072, S, E);
    } SEAM(9);
    if (IN(10)) { phase_topk(p, G, wave, lane); } SEAM(10);
    if (IN(11)) {
        moe_tables(ctl + CW_CNT, lds, tid);
        const LAS int* pref = (const LAS int*)(lds + MOE_OFF);
        MoeUpOrder S{pref, pref + 260, (const int*)(ws + WS_ROWMAP), (const char*)(ws + WS_H2), (const char*)(ws + WS_WEU), G, (int)blockIdx.x};
        EpiUp E{pref, (bf16_t*)(ws + WS_HID)};
        pg8::gemm_phase<EpiUp, MoeUpOrder, true, true>(lds, 1024, 3072, 1024, S, E);
    } SEAM(11);
    if (IN(12)) {
        moe_tables(ctl + CW_CNT, lds, tid);
        const LAS int* pref = (const LAS int*)(lds + MOE_OFF);
        MoeDownOrder S{pref, (const char*)(ws + WS_HID), (const char*)(ws + WS_WED), G, (int)blockIdx.x};
        EpiDown E{pref + 260, (const int*)(ws + WS_ROWMAP), (const float*)(ws + WS_ROWW), (bf16_t*)(ws + WS_YS)};
        pg8::gemm_phase<EpiDown, MoeDownOrder, true, false>(lds, 256, 256, 256, S, E);
    } SEAM(12);
    if (IN(13)) { phase_combine(p, G, tid); }
#undef IN
#undef SEAM
}

extern "C" void kernel_launch(void* const* d_in, const int* in_sizes, int n_in, void* d_out, int out_size, void* d_ws, size_t ws_size, hipStream_t stream) {
    static int grid = 0;
    if (grid == 0) {
        if (n_in != 37 || in_sizes[0] != M * D || out_size != M * D || ws_size < WS_END) { fprintf(stderr, "kernel_launch: unexpected sizes (n_in %d, in0 %d, out %d, ws %zu, need %zu); nothing launched\n", n_in, n_in > 0 ? in_sizes[0] : -1, out_size, ws_size, (size_t)WS_END); grid = -1; return; }
        int dev = 0, cus = 0, per_cu = 0;
        if (hipGetDevice(&dev) != hipSuccess || hipDeviceGetAttribute(&cus, hipDeviceAttributeMultiprocessorCount, dev) != hipSuccess) { grid = -1; return; }
        if (hipFuncSetAttribute((const void*)hybrid_fwd, hipFuncAttributeMaxDynamicSharedMemorySize, LDS_BYTES) != hipSuccess) { fprintf(stderr, "kernel_launch: hipFuncSetAttribute failed\n"); grid = -1; return; }
        if (hipOccupancyMaxActiveBlocksPerMultiprocessor(&per_cu, (const void*)hybrid_fwd, 512, LDS_BYTES) != hipSuccess || per_cu < 1) fprintf(stderr, "kernel_launch: occupancy query reports %d\n", per_cu);
        (void)hipGetLastError();
        grid = cus;
        if (grid != 256) fprintf(stderr, "kernel_launch: %d CUs (built for 256)\n", grid);
    }
    if (grid < 0) return;
    if (hipMemsetAsync((char*)d_ws + WS_CTL, 0, CTL_ZERO_BYTES, stream) != hipSuccess) return;
    Params a{};
    for (int i = 0; i < 37; ++i) a.in[i] = (const float*)d_in[i];
    a.out = (float*)d_out; a.ws = (unsigned char*)d_ws;
#if MK_ONE_LAUNCH
    a.ph_lo = 0; a.ph_hi = NPHASE;
    hipLaunchKernelGGL(hybrid_fwd, dim3(grid), dim3(512), LDS_BYTES, stream, a);
#else
    for (int ph = 0; ph < NPHASE; ++ph) { a.ph_lo = ph; a.ph_hi = ph + 1; hipLaunchKernelGGL(hybrid_fwd, dim3(grid), dim3(512), LDS_BYTES, stream, a); }
#endif
}
```

```cpp
#define MK_ONE_LAUNCH 1
#include <hip/hip_runtime.h>
#include <cstdio>
#include <cstdint>
#include <cmath>

#define LAS __attribute__((address_space(3)))
#define GAS __attribute__((address_space(1)))
typedef unsigned short bf16_t;
typedef short bf16x8 __attribute__((ext_vector_type(8)));
typedef short s16x4 __attribute__((ext_vector_type(4)));
typedef float f32x2 __attribute__((ext_vector_type(2)));
typedef float f32x4 __attribute__((ext_vector_type(4)));
typedef float f32x16 __attribute__((ext_vector_type(16)));
typedef unsigned u32x2 __attribute__((ext_vector_type(2)));
typedef unsigned u32x4 __attribute__((ext_vector_type(4)));

typedef __bf16 bf16x2_t __attribute__((ext_vector_type(2)));
__device__ __forceinline__ unsigned cvt_pk_bf16(float lo, float hi) { f32x2 v = {lo, hi}; bf16x2_t b = __builtin_convertvector(v, bf16x2_t); return __builtin_bit_cast(unsigned, b); }
__device__ __forceinline__ float bf2f(unsigned h) { return __uint_as_float(h << 16); }
__device__ __forceinline__ unsigned f2bf(float f) { unsigned u = __builtin_bit_cast(unsigned, f); return (u + 0x7fffu + ((u >> 16) & 1u)) >> 16; }
__device__ __forceinline__ unsigned pk2(float lo, float hi) { return f2bf(lo) | (f2bf(hi) << 16); }
__device__ __forceinline__ float sigmoidf_(float x) { return 1.f / (1.f + __expf(-x)); }
__device__ __forceinline__ float wave_sum(float v) {
#pragma unroll
    for (int o = 1; o < 64; o <<= 1) v += __shfl_xor(v, o);
    return v;
}

namespace pg8 {
constexpr int BM = 256, BK = 64, HALF = 128, HTB = HALF * BK * 2  , STAGE_BYTES = 8 * HTB, NXCD = 8, WGM = 8;

__host__ __device__ __forceinline__ int lds_byte(int r, int c) { const int st = (r >> 4) * 2 + (c >> 5), rr = r & 15, cc = c & 31, ob = rr * 64 + cc * 2; return st * 1024 + (ob ^ (((ob >> 9) & 1) << 5)); }
__host__ __device__ __forceinline__ void stage_rc(int b, int& R, int& C) { const int st = b / 1024, sb = b % 1024, swz = sb ^ (((sb >> 9) & 1) << 5); R = (st >> 1) * 16 + swz / 64; C = (st & 1) * 32 + (swz % 64) / 2; }
__host__ __device__ __forceinline__ int perm32(int rho) { const int n = rho >> 4, i = rho & 15; return 8 * (i >> 2) + 4 * n + (i & 3); }

struct Unit { int pm, pn, aux; const char* a; const char* b; };

__device__ __forceinline__ void tile_map(int wgid, int nM, int nN, int& pm, int& pn) {
    const int nwg = nM * nN;
    { const int q = nwg / NXCD, r = nwg % NXCD, xcd = wgid % NXCD, off = wgid / NXCD; wgid = (xcd < r ? xcd * (q + 1) : r * (q + 1) + (xcd - r) * q) + off; }
    const int nig = WGM * nN, gid = wgid / nig, fm = gid * WGM, gsz = (nM - fm) < WGM ? (nM - fm) : WGM;
    pm = fm + ((wgid % nig) % gsz); pn = (wgid % nig) / gsz;
}
struct PlainOrder {
    const char* A; const char* Bt; int nM, nN, nwg, G, c; size_t tA, tB;
    __device__ __forceinline__ void init(const void* A_, const void* Bt_, int M, int N, int lda, int ldb, int G_, int c_) {
        A = (const char*)A_; Bt = (const char*)Bt_; nM = M / BM; nN = N / BM; nwg = nM * nN; G = G_; c = c_; tA = (size_t)BM * lda * 2; tB = (size_t)BM * ldb * 2; }
    __device__ __forceinline__ bool next(int i, Unit& u) const {
        const long L = (long)i * G + c; if (L >= nwg) return false;
        tile_map((int)L, nM, nN, u.pm, u.pn); u.aux = 0; u.a = A + (size_t)u.pm * tA; u.b = Bt + (size_t)u.pn * tB; return true; }
    __device__ __forceinline__ int srcrow(const Unit&, int r) const { return r; }
};

template <class Epi, class Sched, bool ALIGN_EPI, bool GATHER>
__device__ __forceinline__ void gemm_phase(LAS unsigned char* lds, const int K, const int lda, const int ldb, const Sched& S, const Epi& E) {
    const int tid = threadIdx.x, wid = __builtin_amdgcn_readfirstlane(tid >> 6), lane = tid & 63, wr = wid >> 2, wc = wid & 3, fr = lane & 15, fq = lane >> 4;
    const int nt = K / BK;
    unsigned voffA[2][2], voffAn[2][2], voffB[2]; int Rr[2], Cc[2];
#pragma unroll
    for (int i = 0; i < 2; ++i) { int R, C; stage_rc(tid * 16 + i * 8192, R, C); const int Rb = Epi::PERM ? ((R & ~31) + perm32(R & 31)) : R;
        Rr[i] = R; Cc[i] = C; voffB[i] = (unsigned)(Rb * ldb + C) * 2u;
        voffA[0][i] = (unsigned)(R * lda + C) * 2u; voffA[1][i] = (unsigned)((R + HALF) * lda + C) * 2u; voffAn[0][i] = voffA[0][i]; voffAn[1][i] = voffA[1][i]; }
    const size_t kstep = (size_t)(BK * 2);
    const size_t hstepB = (size_t)HALF * ldb * 2;
    const unsigned ldsw = (unsigned)wid * 1024u;
    const int aoff = lds_byte(wr * 64 + fr, fq * 8), boff = lds_byte(wc * 32 + fr, fq * 8);
#define PG8_SA(b, h) (((b) * 2 + (h)) * HTB)
#define PG8_SB(b, h) ((4 + (b) * 2 + (h)) * HTB)
#define PG8_STAGE(bufoff, gbase, voff) do { _Pragma("unroll") for (int _i = 0; _i < 2; ++_i) \
        __builtin_amdgcn_global_load_lds((const unsigned*)((const char*)(gbase) + (voff)[_i]), (LAS unsigned*)(lds + (bufoff) + ldsw + _i * 8192), 16, 0, 0); } while (0)
#define PG8_LDA(dst, b, h) do { _Pragma("unroll") for (int m = 0; m < 4; ++m) _Pragma("unroll") for (int k = 0; k < 2; ++k) dst[m][k] = *(const LAS bf16x8*)(lds + PG8_SA(b, h) + aoff + m * 2048 + k * 1024); } while (0)
#define PG8_LDB(dst, b, h) do { _Pragma("unroll") for (int n = 0; n < 2; ++n) _Pragma("unroll") for (int k = 0; k < 2; ++k) dst[n][k] = *(const LAS bf16x8*)(lds + PG8_SB(b, h) + boff + n * 2048 + k * 1024); } while (0)
#define PG8_MMA(ai, bj, At, Bt) do { __builtin_amdgcn_s_setprio(1); _Pragma("unroll") for (int m = 0; m < 4; ++m) _Pragma("unroll") for (int n = 0; n < 2; ++n) _Pragma("unroll") for (int k = 0; k < 2; ++k) \
        acc[ai][bj][m][n] = __builtin_amdgcn_mfma_f32_16x16x32_bf16(Bt[n][k], At[m][k], acc[ai][bj][m][n], 0, 0, 0); __builtin_amdgcn_s_setprio(0); } while (0)
#define PG8_WAIT_V(n) asm volatile("s_waitcnt vmcnt(" #n ")" ::: "memory")
#define PG8_WAIT_L(n) asm volatile("s_waitcnt lgkmcnt(" #n ")" ::: "memory")
#define PG8_BAR __builtin_amdgcn_s_barrier()
#define PG8_SCHED __builtin_amdgcn_sched_barrier(0)
#define PG8_GATHER(dst, u) do { _Pragma("unroll") for (int _h = 0; _h < 2; ++_h) _Pragma("unroll") for (int _i = 0; _i < 2; ++_i) \
        dst[_h][_i] = (unsigned)(S.srcrow(u, _h * HALF + Rr[_i]) * lda + Cc[_i]) * 2u; } while (0)
    Unit cur, nxt; int ui = 0;
    if (!S.next(0, cur)) return;
    f32x4 acc[2][2][4][2];
#pragma unroll
    for (int a = 0; a < 2; ++a)
#pragma unroll
        for (int b = 0; b < 2; ++b)
#pragma unroll
            for (int m = 0; m < 4; ++m)
#pragma unroll
                for (int n = 0; n < 2; ++n) acc[a][b][m][n] = (f32x4){0.f, 0.f, 0.f, 0.f};
    bf16x8 At[4][2], B0[2][2], B1[2][2];
    const char* cA = cur.a; const char* cB = cur.b;
    if constexpr (GATHER) { PG8_GATHER(voffA, cur); }
    PG8_STAGE(PG8_SB(0, 0), cB, voffB); PG8_STAGE(PG8_SB(0, 1), cB + hstepB, voffB); PG8_STAGE(PG8_SA(0, 0), cA, voffA[0]); PG8_STAGE(PG8_SA(0, 1), cA, voffA[1]);
    if (wr == 1) PG8_BAR;
    PG8_WAIT_V(2); PG8_BAR;
    PG8_STAGE(PG8_SB(1, 0), cB + kstep, voffB); PG8_STAGE(PG8_SA(1, 0), cA + kstep, voffA[0]); PG8_STAGE(PG8_SB(1, 1), cB + hstepB + kstep, voffB);
    PG8_WAIT_V(6); PG8_BAR;
    for (;;) {
        const bool has_next = S.next(ui + 1, nxt);
        const char* nA = has_next ? nxt.a : cA; const char* nB = has_next ? nxt.b : cB;
        if constexpr (GATHER) { if (has_next) { PG8_GATHER(voffAn, nxt); } else {
#pragma unroll
            for (int h = 0; h < 2; ++h)
#pragma unroll
                for (int i = 0; i < 2; ++i) voffAn[h][i] = voffA[h][i]; } }
#pragma nounroll
        for (int t = 0; t < nt; t += 2) {
            const bool last = (t == nt - 2);
            const char* a1 = cA + (size_t)(t + 1) * kstep;
            const char* a2 = last ? nA : cA + (size_t)(t + 2) * kstep; const char* b2 = last ? nB : cB + (size_t)(t + 2) * kstep;
            const char* a3 = a2 + kstep; const char* b3 = b2 + kstep;
            unsigned va[2][2];
#pragma unroll
            for (int h = 0; h < 2; ++h)
#pragma unroll
                for (int i = 0; i < 2; ++i) va[h][i] = (GATHER && last) ? voffAn[h][i] : voffA[h][i];
            PG8_LDB(B0, 0, 0); PG8_LDB(B1, 0, 1); PG8_SCHED; PG8_LDA(At, 0, 0); PG8_STAGE(PG8_SA(1, 1), a1, voffA[1]);
            PG8_WAIT_V(8); PG8_WAIT_L(0); PG8_BAR; PG8_MMA(0, 0, At, B0); PG8_MMA(0, 1, At, B1); PG8_BAR; PG8_SCHED;
            PG8_LDA(At, 0, 1); PG8_STAGE(PG8_SB(0, 0), b2, voffB); PG8_STAGE(PG8_SB(0, 1), b2 + hstepB, voffB); PG8_STAGE(PG8_SA(0, 0), a2, va[0]);
            PG8_WAIT_V(8); PG8_WAIT_L(0); PG8_BAR; PG8_MMA(1, 0, At, B0); PG8_MMA(1, 1, At, B1); PG8_BAR; PG8_SCHED;
            PG8_LDB(B0, 1, 0); PG8_LDB(B1, 1, 1); PG8_SCHED; PG8_LDA(At, 1, 0); PG8_STAGE(PG8_SA(0, 1), a2, va[1]);
            PG8_WAIT_V(8); PG8_WAIT_L(0); PG8_BAR; PG8_MMA(0, 0, At, B0); PG8_MMA(0, 1, At, B1); PG8_BAR; PG8_SCHED;
            PG8_LDA(At, 1, 1); PG8_STAGE(PG8_SB(1, 0), b3, voffB); PG8_STAGE(PG8_SB(1, 1), b3 + hstepB, voffB); PG8_STAGE(PG8_SA(1, 0), a3, va[0]);
            PG8_WAIT_V(8); PG8_WAIT_L(0); PG8_BAR; PG8_MMA(1, 0, At, B0); PG8_MMA(1, 1, At, B1); PG8_BAR; PG8_SCHED;
        }
        if constexpr (ALIGN_EPI) { if (wr == 0) PG8_BAR; }
        E(acc, cur, wr, wc, fr, fq);
        if (!has_next) break;
#pragma unroll
        for (int a = 0; a < 2; ++a)
#pragma unroll
            for (int b = 0; b < 2; ++b)
#pragma unroll
                for (int m = 0; m < 4; ++m)
#pragma unroll
                    for (int n = 0; n < 2; ++n) acc[a][b][m][n] = (f32x4){0.f, 0.f, 0.f, 0.f};
        cur = nxt; cA = nA; cB = nB; ++ui;
        if constexpr (GATHER) {
#pragma unroll
            for (int h = 0; h < 2; ++h)
#pragma unroll
                for (int i = 0; i < 2; ++i) voffA[h][i] = voffAn[h][i]; }
        if constexpr (ALIGN_EPI) { if (wr == 1) PG8_BAR; }
    }
    PG8_WAIT_V(0);
    if constexpr (!ALIGN_EPI) { if (wr == 0) PG8_BAR; }
    PG8_BAR;
#undef PG8_SA
#undef PG8_SB
#undef PG8_STAGE
#undef PG8_LDA
#undef PG8_LDB
#undef PG8_MMA
#undef PG8_WAIT_V
#undef PG8_WAIT_L
#undef PG8_BAR
#undef PG8_SCHED
#undef PG8_GATHER
}
}
#define RLX_AGENT __ATOMIC_RELAXED, __HIP_MEMORY_SCOPE_AGENT
#define LDS_WAIT() asm volatile("s_waitcnt lgkmcnt(0)" ::: "memory")
#define VM_WAIT() asm volatile("s_waitcnt vmcnt(0)" ::: "memory")
__device__ __forceinline__ unsigned long long rt() { return __builtin_amdgcn_s_memrealtime(); }

#define XB_TMO      128
#define XB_XCNT(j)  (256  + 64 * (j))
#define XB_XSUB(j)  (1280 + 64 * (j))
#define XB_XGEN(j)  (2304 + 64 * (j))
#define XB_TOP      3328
#define XB_TOPGEN   3392
#define XCD_BAR_WORDS 3456
#define XB_SPIN_CAP (1u << 18)

__device__ __forceinline__ unsigned xb_ld(unsigned* p)              { return __hip_atomic_load(p, __ATOMIC_RELAXED, __HIP_MEMORY_SCOPE_AGENT); }
__device__ __forceinline__ unsigned xb_add(unsigned* p, unsigned v) { return __hip_atomic_fetch_add(p, v, __ATOMIC_RELAXED, __HIP_MEMORY_SCOPE_AGENT); }
__device__ __forceinline__ unsigned xb_xcc_id() { return (unsigned)__builtin_amdgcn_s_getreg((3 << 11) | 20) & 0xFu; }
#define XB_SPIN(cond, bar) do { unsigned _sp = 0; while (cond) { __builtin_amdgcn_s_sleep(1); \
    if ((++_sp & 255u) == 0u) { if (xb_ld(&(bar)[XB_TMO])) break; if (_sp > XB_SPIN_CAP) { atomicAdd(&(bar)[XB_TMO], 1u); break; } } } } while (0)

struct XcdBarrier {
    unsigned* bar; unsigned x;
    volatile LAS unsigned* st;
};

__device__ __forceinline__ XcdBarrier xcd_barrier_post(unsigned* bar, volatile LAS unsigned* st) {
    XcdBarrier b; b.bar = bar; b.x = xb_xcc_id(); b.st = st;
    if (threadIdx.x == 0) (void)xb_add(&bar[XB_XCNT(b.x)], 1u);
    return b;
}
__device__ __forceinline__ void xcd_barrier_complete(unsigned* bar, unsigned x, unsigned& nloc, unsigned& nx) {
    const unsigned G = gridDim.x * gridDim.y * gridDim.z;
    unsigned sum, cnt, mine, sp = 0u;
    for (;;) {
        sum = 0u; cnt = 0u; mine = 0u;
#pragma unroll
        for (unsigned j = 0; j < 16; ++j) { const unsigned c = xb_ld(&bar[XB_XCNT(j)]); sum += c; cnt += (c > 0u) ? 1u : 0u; mine = (j == x) ? c : mine; }
        if (sum == G) break;
        __builtin_amdgcn_s_sleep(1);
        if ((++sp & 255u) == 0u) { if (xb_ld(&bar[XB_TMO])) break; if (sp > XB_SPIN_CAP) { atomicAdd(&bar[XB_TMO], 1u); break; } }
    }
    nloc = mine > 0u ? mine : 1u; nx = cnt > 0u ? cnt : 1u;
}

__device__ __forceinline__ void xcd_barrier(const XcdBarrier& b) {
    asm volatile("s_waitcnt vmcnt(0)" ::: "memory");
    __syncthreads();
    if (threadIdx.x == 0) {
        unsigned* bar = b.bar;
        __builtin_amdgcn_s_waitcnt(0);
        unsigned nloc = b.st[0], nx = b.st[1];
        if (nloc == 0u) { xcd_barrier_complete(bar, b.x, nloc, nx); b.st[0] = nloc; b.st[1] = nx; }
        const unsigned old = xb_add(&bar[XB_XSUB(b.x)], 1u);
        const unsigned gen = old / nloc;
        if (old + 1u == (gen + 1u) * nloc) {
            __builtin_amdgcn_fence(__ATOMIC_RELEASE, "agent");
            asm volatile("s_waitcnt vmcnt(0)" ::: "memory");
            const unsigned og = xb_add(&bar[XB_TOP], 1u);
            const unsigned tg = og / nx;
            if (og + 1u == (tg + 1u) * nx) xb_add(&bar[XB_TOPGEN], 1u);
            else XB_SPIN(xb_ld(&bar[XB_TOPGEN]) == tg, bar);
            __builtin_amdgcn_fence(__ATOMIC_ACQUIRE, "agent");
            xb_add(&bar[XB_XGEN(b.x)], 1u);
            asm volatile("s_waitcnt vmcnt(0)" ::: "memory");
        } else {
            XB_SPIN(xb_ld(&bar[XB_XGEN(b.x)]) == gen, bar);
            __builtin_amdgcn_fence(__ATOMIC_ACQUIRE, "agent");
            asm volatile("s_waitcnt vmcnt(0)" ::: "memory");
        }
    }
    __syncthreads();
}

constexpr int NB = 4, SEQ = 4096, D = 1024, M = NB * SEQ;
constexpr int N1 = 5376;
constexpr int NE = 256, FE = 256, CAP = 16384;
constexpr float QSCALE = 0.125f * 1.4426950408889634f;
constexpr int NPHASE = 14;
#ifndef MK_ONE_LAUNCH
#define MK_ONE_LAUNCH 0
#endif

constexpr size_t MiB = 1u << 20;
constexpr size_t WS_CTL = 0, CTL_ZERO_BYTES = 1 * MiB;
constexpr size_t WS_MODP = 1 * MiB;
constexpr size_t WS_MODF = 1 * MiB + 800 * 1024;
constexpr size_t WS_SCAL = 1 * MiB + 960 * 1024;
constexpr size_t WS_COS = 2 * MiB, WS_SIN = 4 * MiB;
constexpr size_t WS_W1T = 6 * MiB;
constexpr size_t WS_WAT = 17 * MiB, WS_WBT = 18 * MiB;
constexpr size_t WS_WOT = 19 * MiB;
constexpr size_t WS_WRT = 21 * MiB;
constexpr size_t WS_XN = 24 * MiB;
constexpr size_t WS_QN = 56 * MiB, WS_KN = 72 * MiB, WS_VB = 88 * MiB;
constexpr size_t WS_PRW = 104 * MiB;
constexpr size_t WS_GATE = 160 * MiB;
constexpr size_t WS_ACAT = 224 * MiB;
constexpr size_t WS_MIXF = 256 * MiB;
constexpr size_t WS_MIX = 320 * MiB;
constexpr size_t WS_X1 = 352 * MiB;
constexpr size_t WS_H2 = 416 * MiB;
constexpr size_t WS_LOGIT = 512 * MiB;
constexpr size_t WS_ROWMAP = 528 * MiB, WS_ROWW = 544 * MiB;
constexpr size_t WS_RW = 560 * MiB, RW_STRIDE = 32 * MiB;
constexpr size_t WS_WEU = 816 * MiB;
constexpr size_t WS_WED = 1074 * MiB;
constexpr size_t WS_HID = 1203 * MiB;
constexpr size_t WS_YS = 1308 * MiB;
constexpr size_t WS_BON = 1596 * MiB;
#ifdef RK_PROBE
constexpr size_t WS_END = 1968 * MiB;
#else
constexpr size_t WS_END = 1597 * MiB;
#endif
#ifdef RK_PROBE
constexpr size_t WS_RWV1 = 1600 * MiB;
constexpr size_t WS_ACAT2 = 1856 * MiB;
constexpr size_t WS_DBG = 1872 * MiB;
constexpr int CW_PROBE = 9000;
#endif
constexpr int CW_BAR = 4096, CW_CNT = 8192;

constexpr int RING_BYTES = 131072;
constexpr int LDSCTL_OFF = RING_BYTES, MISC_OFF = LDSCTL_OFF + 320, MOE_OFF = LDSCTL_OFF + 1024;
constexpr int LDS_BYTES = 147456;

struct Params { const float* in[37]; float* out; unsigned char* ws; int ph_lo, ph_hi; };

__device__ __forceinline__ void tr_item(const float* W, int N, int k0, int n0, bf16_t* WT, int ldt, int drow0, int dcol0, int mode, LAS float* scr, int lane) {
#pragma unroll 8
    for (int i = 0; i < 32; ++i) { const int kk = 2 * i + (lane >> 5); float v = W[(size_t)(k0 + kk) * N + n0 + (lane & 31)]; if (mode) v = v - bf2f(f2bf(v)); scr[kk * 33 + (lane & 31)] = v; }
    LDS_WAIT(); asm volatile("" ::: "memory");
    const int c = lane & 7;
#pragma unroll
    for (int j = 0; j < 4; ++j) { const int n = (lane >> 3) + 8 * j; const LAS float* s = scr + (8 * c) * 33 + n;
        u32x4 o; o.x = pk2(s[0 * 33], s[1 * 33]); o.y = pk2(s[2 * 33], s[3 * 33]); o.z = pk2(s[4 * 33], s[5 * 33]); o.w = pk2(s[6 * 33], s[7 * 33]);
        *(u32x4*)(WT + (size_t)(drow0 + n) * ldt + dcol0 + 8 * c) = o; }
    LDS_WAIT(); asm volatile("" ::: "memory");
}
__device__ __forceinline__ int qkmap(int n0) { const int qk = n0 >> 9, r = n0 & 511, hd = r >> 6, bj = (r & 63) >> 5; return (qk * 2 + (hd >> 2)) * 256 + bj * 128 + (hd & 3) * 32; }
__device__ __forceinline__ int ugmap(int n0) { return n0 < 256 ? ((n0 >> 7) * 256 + (n0 & 127)) : ((((n0 - 256) >> 7) * 256) + 128 + ((n0 - 256) & 127)); }

__device__ __forceinline__ void phase_prologue(const Params& p, LAS unsigned char* lds, int G, int wave, int lane) {
    unsigned char* ws = p.ws;
    LAS float* scr = (LAS float*)(lds + wave * 16384);
    const int gw = blockIdx.x * 8 + wave, NGW = G * 8;
    constexpr int I_IN = 16 * 104, I_GATE = 16 * 64, I_BA = 8 * 32, I_OUT = 16 * 32, I_R = 16 * 8, I_EU = 257 * 256, I_ED = 257 * 128;
    constexpr int NITEMS = I_IN + I_GATE + 2 * I_BA + I_OUT + I_R + I_EU + I_ED;
    for (int it = gw; it < NITEMS; it += NGW) {
        int r = it;
        if (r < I_IN) { const int kb = r / 104, n0 = (r % 104) * 32; tr_item(p.in[6], 3328, kb * 64, n0, (bf16_t*)(ws + WS_W1T), 1024, n0 < 1024 ? qkmap(n0) : n0, kb * 64, 0, scr, lane); continue; } r -= I_IN;
        if (r < I_GATE) { const int kb = r / 64, n0 = (r % 64) * 32; tr_item(p.in[7], 2048, kb * 64, n0, (bf16_t*)(ws + WS_W1T), 1024, 3328 + n0, kb * 64, 0, scr, lane); continue; } r -= I_GATE;
        if (r < I_BA) { const int kb = r / 32, n0 = (r % 32) * 32; tr_item(p.in[27], 1024, kb * 64, n0, (bf16_t*)(ws + WS_WAT), 512, n0, kb * 64, 0, scr, lane); continue; } r -= I_BA;
        if (r < I_BA) { const int kb = r / 32, n0 = (r % 32) * 32; tr_item(p.in[28], 1024, kb * 64, n0, (bf16_t*)(ws + WS_WBT), 512, n0, kb * 64, 0, scr, lane); continue; } r -= I_BA;
        if (r < I_OUT) { const int kb = r / 32, n0 = (r % 32) * 32; tr_item(p.in[29], 1024, kb * 64, n0, (bf16_t*)(ws + WS_WOT), 1024, n0, kb * 64, 0, scr, lane); continue; } r -= I_OUT;
        if (r < I_R) { const int kb = r / 8, n0 = (r % 8) * 32;
            tr_item(p.in[31], 256, kb * 64, n0, (bf16_t*)(ws + WS_WRT), 3072, n0, kb * 64, 0, scr, lane);
            tr_item(p.in[31], 256, kb * 64, n0, (bf16_t*)(ws + WS_WRT), 3072, n0, 1024 + kb * 64, 0, scr, lane);
            tr_item(p.in[31], 256, kb * 64, n0, (bf16_t*)(ws + WS_WRT), 3072, n0, 2048 + kb * 64, 1, scr, lane); continue; } r -= I_R;
        if (r < I_EU) { const int e = r >> 8, rr = r & 255, kb = rr >> 4, n0 = (rr & 15) * 32;
            const float* W = e < 256 ? p.in[33] + (size_t)e * 1024 * 512 : p.in[35];
            tr_item(W, 512, kb * 64, n0, (bf16_t*)(ws + WS_WEU) + (size_t)e * 512 * 1024, 1024, ugmap(n0), kb * 64, 0, scr, lane); continue; } r -= I_EU;
        { const int e = r >> 7, rr = r & 127, kb = rr >> 5, n0 = (rr & 31) * 32;
            const float* W = e < 256 ? p.in[34] + (size_t)e * 256 * 1024 : p.in[36];
            tr_item(W, 1024, kb * 64, n0, (bf16_t*)(ws + WS_WED) + (size_t)e * 1024 * 256, 256, n0, kb * 64, 0, scr, lane); }
    }
    { const float* c = p.in[1]; const float* wa = p.in[3]; float* MODP = (float*)(ws + WS_MODP);
      for (int item = gw; item < 768; item += NGW) { const int ks = item / 96, n0 = (item % 96) * 64, k0 = ks * 128;
        float s0[4], s1[4], acc[4];
#pragma unroll
        for (int b = 0; b < 4; ++b) { const float a = c[b * 1024 + k0 + lane], a2 = c[b * 1024 + k0 + 64 + lane]; s0[b] = a * sigmoidf_(a); s1[b] = a2 * sigmoidf_(a2); acc[b] = 0.f; }
#pragma unroll 8
        for (int kk = 0; kk < 64; ++kk) { const float w = wa[(size_t)(k0 + kk) * 6144 + n0 + lane];
#pragma unroll
            for (int b = 0; b < 4; ++b) acc[b] += __shfl(s0[b], kk) * w; }
#pragma unroll 8
        for (int kk = 0; kk < 64; ++kk) { const float w = wa[(size_t)(k0 + 64 + kk) * 6144 + n0 + lane];
#pragma unroll
            for (int b = 0; b < 4; ++b) acc[b] += __shfl(s1[b], kk) * w; }
#pragma unroll
        for (int b = 0; b < 4; ++b) MODP[(ks * 4 + b) * 6144 + n0 + lane] = acc[b]; } }
    { const int* pos = (const int*)p.in[2]; float* ct = (float*)(ws + WS_COS); float* st = (float*)(ws + WS_SIN);
      const double INVF[32] = {1, 0.74989420933245587, 0.56234132519034907, 0.42169650342858228, 0.31622776601683794, 0.23713737056616555, 0.17782794100389226, 0.1333521432163324,
          0.10000000000000001, 0.074989420933245579, 0.056234132519034905, 0.042169650342858224, 0.031622776601683791, 0.02371373705661655, 0.017782794100389229, 0.013335214321633241,
          0.01, 0.0074989420933245588, 0.005623413251903491, 0.0042169650342858229, 0.003162277660168379, 0.0023713737056616549, 0.001778279410038923, 0.0013335214321633241,
          0.001, 0.00074989420933245575, 0.0005623413251903491, 0.00042169650342858229, 0.00031622776601683794, 0.00023713737056616554, 0.00017782794100389227, 0.0001333521432163324};
      for (int idx = gw * 64 + lane; idx < M * 32; idx += NGW * 64) { const int row = idx >> 5, i = idx & 31;
        double inv = 1.0;
#pragma unroll
        for (int j = 0; j < 32; ++j) inv = (i == j) ? INVF[j] : inv;
        const double rev = (double)pos[row] * inv * 0.15915494309189535; double fr = rev - floor(rev); if (fr > 0.5) fr -= 1.0;
        const float a = (float)(fr * 6.283185307179586);
        ct[idx] = __cosf(a); st[idx] = __sinf(a); } }
    if (gw == 0) { const float s1 = wave_sum(p.in[11][lane] * p.in[12][lane]), s2 = wave_sum(p.in[13][lane] * p.in[14][lane]);
        if (lane == 0) ((float*)(ws + WS_SCAL))[0] = expf(s1) - expf(s2) + 0.2f; }
}

__device__ __forceinline__ void norm_row(const float* xrow, const LAS float* mul, const LAS float* add, int lane, f32x4 (&y)[4]) {
    const f32x4* xr = (const f32x4*)xrow + lane; float s = 0.f;
#pragma unroll
    for (int j = 0; j < 4; ++j) { y[j] = xr[64 * j]; s += (y[j].x * y[j].x + y[j].y * y[j].y) + (y[j].z * y[j].z + y[j].w * y[j].w); }
    const float rstd = 1.f / sqrtf(wave_sum(s) * (1.f / D) + 1e-6f);
#pragma unroll
    for (int j = 0; j < 4; ++j) { const f32x4 mu = *(const LAS f32x4*)(mul + 4 * lane + 256 * j), ad = *(const LAS f32x4*)(add + 4 * lane + 256 * j); y[j] = y[j] * rstd * mu + ad; }
}
__device__ __forceinline__ void phase_norm1(const Params& p, LAS unsigned char* lds, int G, int tid, int wave, int lane) {
    unsigned char* ws = p.ws; const float* MODP = (const float*)(ws + WS_MODP); const float* bada = p.in[4]; float* MODF = (float*)(ws + WS_MODF);
    LAS float* mul = (LAS float*)lds; LAS float* add = mul + 1024;
    const int rows_per = M / G, r0 = blockIdx.x * rows_per, b = r0 / SEQ;
    for (int j = tid; j < 1024; j += 512) { float sh = bada[j], sc = bada[1024 + j];
#pragma unroll
        for (int ks = 0; ks < 8; ++ks) { sh += MODP[(ks * 4 + b) * 6144 + j]; sc += MODP[(ks * 4 + b) * 6144 + 1024 + j]; }
        mul[j] = p.in[5][j] * (1.f + sc); add[j] = sh; }
    for (int idx = blockIdx.x * 512 + tid; idx < 4 * 6144; idx += G * 512) { const int bb = idx / 6144, j = idx % 6144; float s = bada[j];
#pragma unroll
        for (int ks = 0; ks < 8; ++ks) s += MODP[(ks * 4 + bb) * 6144 + j];
        MODF[idx] = s; }
    __syncthreads();
    bf16_t* XN = (bf16_t*)(ws + WS_XN);
    for (int rr = wave; rr < rows_per; rr += 8) { const int row = r0 + rr; f32x4 y[4]; norm_row(p.in[0] + (size_t)row * D, mul, add, lane, y);
        unsigned long long* o8 = (unsigned long long*)(XN + (size_t)row * D) + lane;
#pragma unroll
        for (int j = 0; j < 4; ++j) o8[64 * j] = (unsigned long long)pk2(y[j].x, y[j].y) | ((unsigned long long)pk2(y[j].z, y[j].w) << 32); }
}
__device__ __forceinline__ void phase_norm2(const Params& p, LAS unsigned char* lds, int G, int tid, int wave, int lane) {
    unsigned char* ws = p.ws; const float* MODF = (const float*)(ws + WS_MODF);
    LAS float* mul = (LAS float*)lds; LAS float* add = mul + 1024;
    const int rows_per = M / G, r0 = blockIdx.x * rows_per, b = r0 / SEQ;
    for (int j = tid; j < 1024; j += 512) { mul[j] = p.in[30][j] * (1.f + MODF[b * 6144 + 4096 + j]); add[j] = MODF[b * 6144 + 3072 + j]; }
    __syncthreads();
    bf16_t* H2 = (bf16_t*)(ws + WS_H2); const float* X1 = (const float*)(ws + WS_X1);
    for (int rr = wave; rr < rows_per; rr += 8) { const int row = r0 + rr; f32x4 y[4]; norm_row(X1 + (size_t)row * D, mul, add, lane, y);
        unsigned long long* o8 = (unsigned long long*)(H2 + (size_t)row * 3072) + lane;
#pragma unroll
        for (int j = 0; j < 4; ++j) { const unsigned h0 = pk2(y[j].x, y[j].y), h1 = pk2(y[j].z, y[j].w);
            const unsigned l0 = pk2(y[j].x - bf2f(h0 & 0xffffu), y[j].y - bf2f(h0 >> 16)), l1 = pk2(y[j].z - bf2f(h1 & 0xffffu), y[j].w - bf2f(h1 >> 16));
            const unsigned long long hv = (unsigned long long)h0 | ((unsigned long long)h1 << 32), lv = (unsigned long long)l0 | ((unsigned long long)l1 << 32);
            o8[64 * j] = hv; o8[256 + 64 * j] = lv; o8[512 + 64 * j] = hv; } }
}

using pg8::Unit; using pg8::BM; using pg8::HALF;
__device__ __forceinline__ u32x4 pack8(const f32x4& a, const f32x4& b) { u32x4 w; w.x = cvt_pk_bf16(a[0], a[1]); w.y = cvt_pk_bf16(a[2], a[3]); w.z = cvt_pk_bf16(b[0], b[1]); w.w = cvt_pk_bf16(b[2], b[3]); return w; }
__device__ __forceinline__ void unpack8(const u32x4& w, f32x4& a, f32x4& b) { a = (f32x4){bf2f(w.x & 0xffffu), bf2f(w.x >> 16), bf2f(w.y & 0xffffu), bf2f(w.y >> 16)}; b = (f32x4){bf2f(w.z & 0xffffu), bf2f(w.z >> 16), bf2f(w.w & 0xffffu), bf2f(w.w >> 16)}; }

struct EpiG1 {
    static constexpr bool PERM = true;
    unsigned char* ws; const float *qg, *kg, *cosT, *sinT, *bgate;
    __device__ __forceinline__ void operator()(const f32x4 (&acc)[2][2][4][2], const Unit& u, int wr, int wc, int fr, int fq) const {
        const int row0 = u.pm * BM + wr * 64 + fr;
        if (u.pn < 4) {
            const bool isq = u.pn < 2; const float* g = isq ? qg : kg; bf16_t* O = (bf16_t*)(ws + (isq ? WS_QN : WS_KN)); const float osc = isq ? QSCALE : 1.f;
            const int hd = (u.pn & 1) * 4 + wc;
            f32x4 gv[2][2];
#pragma unroll
            for (int bj = 0; bj < 2; ++bj)
#pragma unroll
                for (int n = 0; n < 2; ++n) gv[bj][n] = *(const f32x4*)(g + 32 * bj + 8 * fq + 4 * n);
#pragma unroll
            for (int ai = 0; ai < 2; ++ai)
#pragma unroll
                for (int m = 0; m < 4; ++m) { const int row = row0 + ai * HALF + m * 16; float ss = 0.f;
#pragma unroll
                    for (int bj = 0; bj < 2; ++bj)
#pragma unroll
                        for (int n = 0; n < 2; ++n) { const f32x4 x = acc[ai][bj][m][n]; ss += (x[0] * x[0] + x[1] * x[1]) + (x[2] * x[2] + x[3] * x[3]); }
                    ss += __shfl_xor(ss, 16); ss += __shfl_xor(ss, 32);
                    const float rs = osc / sqrtf(ss * (1.f / 64.f) + 1e-6f);
                    f32x4 o1[2], o2[2];
#pragma unroll
                    for (int n = 0; n < 2; ++n) { const f32x4 c4 = *(const f32x4*)(cosT + (size_t)row * 32 + 8 * fq + 4 * n), s4 = *(const f32x4*)(sinT + (size_t)row * 32 + 8 * fq + 4 * n);
                        const f32x4 x1 = acc[ai][0][m][n] * gv[0][n] * rs, x2 = acc[ai][1][m][n] * gv[1][n] * rs;
                        o1[n] = x1 * c4 - x2 * s4; o2[n] = x2 * c4 + x1 * s4; }
                    bf16_t* dst = O + (size_t)row * 512 + hd * 64 + 8 * fq;
                    *(u32x4*)dst = pack8(o1[0], o1[1]); *(u32x4*)(dst + 32) = pack8(o2[0], o2[1]); }
        } else {
            int colt = u.pn * BM; size_t boff; int ld; bool gate = false;
            if (u.pn < 6) { boff = WS_VB; ld = 512; colt -= 1024; } else if (u.pn < 13) { boff = WS_PRW; ld = 1792; colt -= 1536; } else { boff = WS_GATE; ld = 2048; colt -= 3328; gate = true; }
            bf16_t* base = (bf16_t*)(ws + boff);
            const int col0 = colt + wc * 32 + 8 * fq;
            f32x4 bv[2][2];
#pragma unroll
            for (int bj = 0; bj < 2; ++bj)
#pragma unroll
                for (int n = 0; n < 2; ++n) bv[bj][n] = gate ? *(const f32x4*)(bgate + col0 + bj * HALF + 4 * n) : (f32x4){0.f, 0.f, 0.f, 0.f};
#pragma unroll
            for (int ai = 0; ai < 2; ++ai)
#pragma unroll
                for (int m = 0; m < 4; ++m) { bf16_t* rowp = base + (size_t)(row0 + ai * HALF + m * 16) * ld + col0;
#pragma unroll
                    for (int bj = 0; bj < 2; ++bj) { f32x4 v0 = acc[ai][bj][m][0] + bv[bj][0], v1 = acc[ai][bj][m][1] + bv[bj][1];
                        if (gate) {
#pragma unroll
                            for (int i = 0; i < 4; ++i) { v0[i] = sigmoidf_(v0[i]); v1[i] = sigmoidf_(v1[i]); } }
                        *(u32x4*)(rowp + bj * HALF) = pack8(v0, v1); } }
        }
    }
};

struct BranchOrder {
    const char *A, *Wa, *Wb; int G, c;
    __device__ __forceinline__ bool next(int i, Unit& u) const { const int tile = (i >> 1) * G + c; if (tile >= 256) return false;
        pg8::tile_map(tile, 64, 4, u.pm, u.pn); u.aux = i & 1; u.a = A + (size_t)u.pm * BM * 1024 * 2 + (u.aux ? 1024 : 0); u.b = (u.aux ? Wb : Wa) + (size_t)u.pn * BM * 512 * 2; return true; }
    __device__ __forceinline__ int srcrow(const Unit&, int r) const { return r; }
};
struct EpiBranch {
    static constexpr bool PERM = true;
    const bf16_t* GATE; float* MIXF; bf16_t* MIX;
    __device__ __forceinline__ void operator()(const f32x4 (&acc)[2][2][4][2], const Unit& u, int wr, int wc, int fr, int fq) const {
        const int row0 = u.pm * BM + wr * 64 + fr, col0 = u.pn * BM + wc * 32 + 8 * fq;
#pragma unroll
        for (int ai = 0; ai < 2; ++ai)
#pragma unroll
            for (int m = 0; m < 4; ++m) { const size_t row = (size_t)(row0 + ai * HALF + m * 16);
#pragma unroll
                for (int bj = 0; bj < 2; ++bj) { const int col = col0 + bj * HALF;
                    f32x4 g0, g1; unpack8(*(const u32x4*)(GATE + row * 2048 + (u.aux ? 1024 : 0) + col), g0, g1);
                    float* mf = MIXF + row * 1024 + col;
                    if (u.aux == 0) { *(f32x4*)mf = g0 * acc[ai][bj][m][0]; *(f32x4*)(mf + 4) = g1 * acc[ai][bj][m][1]; }
                    else { const f32x4 t0 = *(const f32x4*)mf + g0 * acc[ai][bj][m][0], t1 = *(const f32x4*)(mf + 4) + g1 * acc[ai][bj][m][1]; *(u32x4*)(MIX + row * 1024 + col) = pack8(t0, t1); } } }
    }
};
struct EpiOut {
    static constexpr bool PERM = true;
    const float* X; const float* MODF; float* X1;
    __device__ __forceinline__ void operator()(const f32x4 (&acc)[2][2][4][2], const Unit& u, int wr, int wc, int fr, int fq) const {
        const int row0 = u.pm * BM + wr * 64 + fr, col0 = u.pn * BM + wc * 32 + 8 * fq, b = (u.pm * BM) / SEQ;
        f32x4 gt[2][2];
#pragma unroll
        for (int bj = 0; bj < 2; ++bj)
#pragma unroll
            for (int n = 0; n < 2; ++n) gt[bj][n] = *(const f32x4*)(MODF + b * 6144 + 2048 + col0 + bj * HALF + 4 * n);
#pragma unroll
        for (int ai = 0; ai < 2; ++ai)
#pragma unroll
            for (int m = 0; m < 4; ++m) { const size_t off = (size_t)(row0 + ai * HALF + m * 16) * D + col0;
#pragma unroll
                for (int bj = 0; bj < 2; ++bj)
#pragma unroll
                    for (int n = 0; n < 2; ++n) { const size_t o = off + bj * HALF + 4 * n; *(f32x4*)(X1 + o) = *(const f32x4*)(X + o) + gt[bj][n] * acc[ai][bj][m][n]; } }
    }
};
struct EpiF32 {
    static constexpr bool PERM = true;
    float* O; int ldc;
    __device__ __forceinline__ void operator()(const f32x4 (&acc)[2][2][4][2], const Unit& u, int wr, int wc, int fr, int fq) const {
        const int row0 = u.pm * BM + wr * 64 + fr, col0 = u.pn * BM + wc * 32 + 8 * fq;
#pragma unroll
        for (int ai = 0; ai < 2; ++ai)
#pragma unroll
            for (int m = 0; m < 4; ++m) { float* rowp = O + (size_t)(row0 + ai * HALF + m * 16) * ldc + col0;
#pragma unroll
                for (int bj = 0; bj < 2; ++bj)
#pragma unroll
                    for (int n = 0; n < 2; ++n) *(f32x4*)(rowp + bj * HALF + 4 * n) = acc[ai][bj][m][n]; }
    }
};

__device__ __forceinline__ void moe_tables(const unsigned* CNT, LAS unsigned char* lds, int tid) {
    LAS int* pref = (LAS int*)(lds + MOE_OFF); LAS int* cntl = pref + 260;
    __syncthreads();
    if (tid < 257) cntl[tid] = tid < 256 ? (int)__hip_atomic_load((unsigned*)CNT + tid, RLX_AGENT) : M;
    __syncthreads();
    if (tid == 0) { int s = 0; for (int e = 0; e < 257; ++e) { pref[e] = s; s += (cntl[e] + 255) >> 8; } pref[257] = s; }
    __syncthreads();
}
__device__ __forceinline__ int moe_find(const LAS int* pref, int j) { int lo = 0, hi = 257; while (hi - lo > 1) { const int mid = (lo + hi) >> 1; if (pref[mid] <= j) lo = mid; else hi = mid; } return lo; }
struct MoeUpOrder {
    const LAS int* pref; const LAS int* cntl; const int* rowmap; const char* A; const char* W; int G, c;
    __device__ __forceinline__ bool next(int i, Unit& u) const { const int L = i * G + c; if (L >= pref[257] * 2) return false; const int j = L >> 1, e = moe_find(pref, j);
        u.pm = j - pref[e]; u.pn = L & 1; u.aux = e; u.a = A; u.b = W + (size_t)e * (512 * 1024 * 2) + (size_t)u.pn * (BM * 1024 * 2); return true; }
    __device__ __forceinline__ int srcrow(const Unit& u, int r) const { const int lr = u.pm * BM + r, e = u.aux; if (e == 256) return lr; const int n = cntl[e]; return rowmap[e * CAP + (lr < n ? lr : 0)] >> 4; }
};
struct EpiUp {
    static constexpr bool PERM = true;
    const LAS int* pref; bf16_t* HID;
    __device__ __forceinline__ void operator()(const f32x4 (&acc)[2][2][4][2], const Unit& u, int wr, int wc, int fr, int fq) const {
        const int hrow0 = (pref[u.aux] + u.pm) * BM + wr * 64 + fr, col0 = u.pn * HALF + wc * 32 + 8 * fq;
#pragma unroll
        for (int ai = 0; ai < 2; ++ai)
#pragma unroll
            for (int m = 0; m < 4; ++m) { f32x4 h[2];
#pragma unroll
                for (int n = 0; n < 2; ++n) { const f32x4 g = acc[ai][0][m][n], up = acc[ai][1][m][n];
#pragma unroll
                    for (int i = 0; i < 4; ++i) h[n][i] = g[i] * sigmoidf_(g[i]) * up[i]; }
                *(u32x4*)(HID + (size_t)(hrow0 + ai * HALF + m * 16) * FE + col0) = pack8(h[0], h[1]); }
    }
};
struct MoeDownOrder {
    const LAS int* pref; const char* A; const char* W; int G, c;
    __device__ __forceinline__ bool next(int i, Unit& u) const { const int L = i * G + c; if (L >= pref[257] * 4) return false; const int j = L >> 2, e = moe_find(pref, j);
        u.pm = j - pref[e]; u.pn = L & 3; u.aux = e; u.a = A + (size_t)j * (BM * FE * 2); u.b = W + (size_t)e * (1024 * 256 * 2) + (size_t)u.pn * (BM * FE * 2); return true; }
    __device__ __forceinline__ int srcrow(const Unit&, int r) const { return r; }
};
struct EpiDown {
    static constexpr bool PERM = true;
    const LAS int* cntl; const int* rowmap; const float* roww; bf16_t* YS;
    __device__ __forceinline__ void operator()(const f32x4 (&acc)[2][2][4][2], const Unit& u, int wr, int wc, int fr, int fq) const {
        const int e = u.aux, n = cntl[e], lr0 = u.pm * BM + wr * 64 + fr, col0 = u.pn * BM + wc * 32 + 8 * fq;
#pragma unroll
        for (int ai = 0; ai < 2; ++ai)
#pragma unroll
            for (int m = 0; m < 4; ++m) { const int lr = lr0 + ai * HALF + m * 16;
                if (lr < n) { int v; float w; if (e == 256) { v = lr * 16 + 8; w = 1.f; } else { v = rowmap[e * CAP + lr]; w = roww[e * CAP + lr]; }
                    bf16_t* dst = YS + ((size_t)(v >> 4) * 9 + (v & 15)) * 1024 + col0;
#pragma unroll
                    for (int bj = 0; bj < 2; ++bj) *(u32x4*)(dst + bj * HALF) = pack8(acc[ai][bj][m][0] * w, acc[ai][bj][m][1] * w); } }
    }
};

namespace att {
constexpr int LDS_K0 = 0, LDS_K1 = 8192, LDS_V = 16384, LDS_WS = 32768, LDS_X = 36864;
__device__ __forceinline__ int crow(int r, int hi) { return (r & 3) + 8 * (r >> 2) + 4 * hi; }
__device__ __forceinline__ void qkt(f32x16& p0, f32x16& p1, const LAS unsigned char* Kslot, const bf16x8* qr, int r32, int hi) {
    const LAS unsigned char* kb = Kslot + hi * 1024 + r32 * 16; const f32x16 z = {};
#pragma unroll
    for (int d0 = 0; d0 < 4; ++d0) { const bf16x8 b0 = *(const LAS bf16x8*)(kb + d0 * 2048), b1 = *(const LAS bf16x8*)(kb + d0 * 2048 + 512);
        if (d0 == 0) { p0 = __builtin_amdgcn_mfma_f32_32x32x16_bf16(b0, qr[0], z, 0, 0, 0); p1 = __builtin_amdgcn_mfma_f32_32x32x16_bf16(b1, qr[0], z, 0, 0, 0); }
        else { p0 = __builtin_amdgcn_mfma_f32_32x32x16_bf16(b0, qr[d0], p0, 0, 0, 0); p1 = __builtin_amdgcn_mfma_f32_32x32x16_bf16(b1, qr[d0], p1, 0, 0, 0); } }
}
__device__ __forceinline__ void pv4(f32x16* o, int vb, bf16x8 pa0, bf16x8 pa1, bf16x8 pa2, bf16x8 pa3) {
#pragma unroll
    for (int d0 = 0; d0 < 4; ++d0) { s16x4 lo[4], hi[4];
#pragma unroll
        for (int ks = 0; ks < 4; ++ks) {
            asm volatile("ds_read_b64_tr_b16 %0,%1 offset:%c2" : "=&v"(lo[ks]) : "v"(vb), "i"(d0 * 4096 + ks * 1024) : "memory");
            asm volatile("ds_read_b64_tr_b16 %0,%1 offset:%c2" : "=&v"(hi[ks]) : "v"(vb), "i"(d0 * 4096 + ks * 1024 + 512) : "memory"); }
        asm volatile("s_waitcnt lgkmcnt(0)" ::: "memory"); __builtin_amdgcn_sched_barrier(0);
#define PK(k) (bf16x8){lo[k][0], lo[k][1], lo[k][2], lo[k][3], hi[k][0], hi[k][1], hi[k][2], hi[k][3]}
        o[d0] = __builtin_amdgcn_mfma_f32_32x32x16_bf16(pa0, PK(0), o[d0], 0, 0, 0);
        o[d0] = __builtin_amdgcn_mfma_f32_32x32x16_bf16(pa1, PK(1), o[d0], 0, 0, 0);
        o[d0] = __builtin_amdgcn_mfma_f32_32x32x16_bf16(pa2, PK(2), o[d0], 0, 0, 0);
        o[d0] = __builtin_amdgcn_mfma_f32_32x32x16_bf16(pa3, PK(3), o[d0], 0, 0, 0);
#undef PK
    }
}
__device__ __forceinline__ void attn_unit(int b, int h, int qb, const bf16_t* Qn, const bf16_t* Kn, const bf16_t* Vb, bf16_t* ACAT, const float* subg, float lam, LAS unsigned char* lds) {
    const int tid = threadIdx.x, lane = tid & 63, r32 = lane & 31, hi = lane >> 5; const int wid = __builtin_amdgcn_readfirstlane(tid >> 6), st = wid >> 2, wq = wid & 3;
    const long rowbase = (long)b * SEQ; const int q0 = qb * 128;
    const bf16_t* Qw = Qn + (rowbase + q0 + 32 * wq) * 512 + (2 * h + st) * 64;
    bf16x8 qr[4];
#pragma unroll
    for (int d0 = 0; d0 < 4; ++d0) qr[d0] = *(const bf16x8*)(Qw + (long)r32 * 512 + d0 * 16 + hi * 8);
    const int ntw = (q0 + 32 * wq) / 64 + 1, NT = q0 / 64 + 2;
    float m_run = -1e30f, l_run = 0.f; f32x16 o[4];
#pragma unroll
    for (int d0 = 0; d0 < 4; ++d0) o[d0] = f32x16{};
    LAS float* wsf = (LAS float*)(lds + LDS_WS) + wid * 128;
    const LAS unsigned char* Ks = lds + (st ? LDS_K1 : LDS_K0);
    const int vb0 = (int)(unsigned)(uintptr_t)(lds + LDS_V) + ((lane >> 4) & 1) * 32 + (lane & 3) * 8 + (4 * hi + ((lane & 15) >> 2)) * 64;
    for (int t = 0; t < NT; ++t) {
        __syncthreads();
        { const int c8 = tid >> 6, kv = tid & 63; const bf16_t* kr = Kn + (rowbase + 64 * t + kv) * 512 + (2 * h) * 64 + c8 * 8;
          const u32x4 k0v = *(const u32x4*)kr, k1v = *(const u32x4*)(kr + 64);
          *(LAS u32x4*)(lds + LDS_K0 + c8 * 1024 + kv * 16) = k0v; *(LAS u32x4*)(lds + LDS_K1 + c8 * 1024 + kv * 16) = k1v;
#pragma unroll
          for (int j = 0; j < 2; ++j) { const int pidx = tid + 512 * j, ch = pidx & 3, key = (pidx >> 2) & 15, kg = (pidx >> 6) & 3, dblk = pidx >> 8;
              const u32x4 vv = *(const u32x4*)(Vb + (rowbase + 64 * t + kg * 16 + key) * 512 + h * 128 + dblk * 32 + ch * 8); *(LAS u32x4*)(lds + LDS_V + pidx * 16) = vv; } }
        __syncthreads();
        if (t < ntw) {
            f32x16 p0, p1; qkt(p0, p1, Ks, qr, r32, hi);
            float rm = p0[0];
#pragma unroll
            for (int r = 0; r < 16; ++r) { rm = fmaxf(rm, p0[r]); rm = fmaxf(rm, p1[r]); }
            rm = fmaxf(rm, __shfl_xor(rm, 32));
            const float mnew = fmaxf(m_run, rm), alpha = __builtin_amdgcn_exp2f(m_run - mnew); m_run = mnew;
            float s = 0.f;
#pragma unroll
            for (int r = 0; r < 16; ++r) { p0[r] = __builtin_amdgcn_exp2f(p0[r] - mnew); p1[r] = __builtin_amdgcn_exp2f(p1[r] - mnew); s += p0[r] + p1[r]; }
            s += __shfl_xor(s, 32); l_run = l_run * alpha + s;
            if (hi == 0) wsf[r32] = alpha;
            LDS_WAIT();
#pragma unroll
            for (int r = 0; r < 16; ++r) { const float f = wsf[crow(r, hi)];
#pragma unroll
                for (int d0 = 0; d0 < 4; ++d0) o[d0][r] *= f; }
            u32x4 pw0, pw1, pw2, pw3;
#define PKW(P, B) cvt_pk_bf16(P[B], P[B + 1])
            pw0 = (u32x4){PKW(p0, 0), PKW(p0, 2), PKW(p0, 4), PKW(p0, 6)}; pw1 = (u32x4){PKW(p0, 8), PKW(p0, 10), PKW(p0, 12), PKW(p0, 14)};
            pw2 = (u32x4){PKW(p1, 0), PKW(p1, 2), PKW(p1, 4), PKW(p1, 6)}; pw3 = (u32x4){PKW(p1, 8), PKW(p1, 10), PKW(p1, 12), PKW(p1, 14)};
#undef PKW
            pv4(o, vb0, __builtin_bit_cast(bf16x8, pw0), __builtin_bit_cast(bf16x8, pw1), __builtin_bit_cast(bf16x8, pw2), __builtin_bit_cast(bf16x8, pw3));
        }
    }
    if (hi == 0) wsf[32 + r32] = l_run;
    LDS_WAIT();
    float rli[16];
#pragma unroll
    for (int r = 0; r < 16; ++r) rli[r] = 1.f / wsf[32 + crow(r, hi)];
    LAS float* X = (LAS float*)(lds + LDS_X) + wq * (32 * 128);
    if (st == 1) {
#pragma unroll
        for (int d0 = 0; d0 < 4; ++d0)
#pragma unroll
            for (int r = 0; r < 16; ++r) X[crow(r, hi) * 128 + d0 * 32 + r32] = o[d0][r] * rli[r];
    }
    __syncthreads();
    if (st == 0) {
        float ss[16];
#pragma unroll
        for (int r = 0; r < 16; ++r) ss[r] = 0.f;
#pragma unroll
        for (int d0 = 0; d0 < 4; ++d0)
#pragma unroll
            for (int r = 0; r < 16; ++r) { const float v = o[d0][r] * rli[r] - lam * X[crow(r, hi) * 128 + d0 * 32 + r32]; o[d0][r] = v; ss[r] += v * v; }
#pragma unroll
        for (int r = 0; r < 16; ++r) {
#pragma unroll
            for (int off = 1; off < 32; off <<= 1) ss[r] += __shfl_xor(ss[r], off);
            ss[r] = 0.8f / sqrtf(ss[r] * (1.f / 128.f) + 1e-5f); }
#pragma unroll
        for (int d0 = 0; d0 < 4; ++d0) { const float g = subg[d0 * 32 + r32];
#pragma unroll
            for (int r = 0; r < 16; ++r) ACAT[(size_t)(rowbase + q0 + 32 * wq + crow(r, hi)) * 1024 + h * 128 + d0 * 32 + r32] = (bf16_t)f2bf(o[d0][r] * ss[r] * g); }
    }
}
}


namespace rk {
typedef bf16x8 frag;
constexpr size_t CELL = 131072;
constexpr int S_KKE = 0, S_RD = 8192, S_BI = 16384, S_KI = 24576, F_BIB = 32768, F_KIB = 40960, F_VB = 49152, F_ARBA = 57344, F_ARKA = 65536, O_P = 73728, O_QT = 81920, O_GA = 98304, O_Y0 = 106496, O_S0B = 122880;
__device__ __forceinline__ int crow(int r, int hi) { return (r & 3) + 8 * (r >> 2) + 4 * hi; }
__device__ __forceinline__ void swap32(unsigned& a, unsigned& b) { auto r = __builtin_amdgcn_permlane32_swap(a, b, false, false); a = r[0]; b = r[1]; }
__device__ __forceinline__ void swap32f(float& a, float& b) { unsigned ua = __float_as_uint(a), ub = __float_as_uint(b); swap32(ua, ub); a = __uint_as_float(ua); b = __uint_as_float(ub); }
__device__ __forceinline__ f32x16 mma(frag a, frag b, f32x16 c) { return __builtin_amdgcn_mfma_f32_32x32x16_bf16(a, b, c, 0, 0, 0); }
__device__ __forceinline__ frag mkfrag(unsigned a, unsigned b, unsigned c, unsigned d) { u32x4 w = {a, b, c, d}; return __builtin_bit_cast(frag, w); }
__device__ __forceinline__ frag pack_half(const f32x16& x, int half) { const int b = 8 * half; return mkfrag(cvt_pk_bf16(x[b], x[b + 1]), cvt_pk_bf16(x[b + 2], x[b + 3]), cvt_pk_bf16(x[b + 4], x[b + 5]), cvt_pk_bf16(x[b + 6], x[b + 7])); }
__device__ __forceinline__ void load_rm(const GAS bf16_t* S, int lane, frag (&f)[2][4]) {
#pragma unroll
    for (int t = 0; t < 2; ++t)
#pragma unroll
        for (int s = 0; s < 4; ++s) f[t][s] = *(const GAS frag*)(S + (32 * t + (lane & 31)) * 64 + 16 * s + 8 * (lane >> 5));
}
__device__ __forceinline__ void dump_frag(GAS unsigned char* F, int f, int lane, frag v) { *(GAS frag*)(F + f * 1024 + lane * 16) = v; }
__device__ __forceinline__ frag load_frag(const GAS unsigned char* F, int f, int lane) { return *(const GAS frag*)(F + f * 1024 + lane * 16); }
__device__ __forceinline__ void dump_tile_f32(GAS unsigned char* F, int tile, int lane, const f32x16& x) {
#pragma unroll
    for (int q = 0; q < 4; ++q) *(GAS f32x4*)(F + (tile * 4 + q) * 1024 + lane * 16) = (f32x4){x[4 * q], x[4 * q + 1], x[4 * q + 2], x[4 * q + 3]};
}
__device__ __forceinline__ f32x16 load_tile_f32(const GAS unsigned char* F, int tile, int lane) { f32x16 x;
#pragma unroll
    for (int q = 0; q < 4; ++q) { const f32x4 v = *(const GAS f32x4*)(F + (tile * 4 + q) * 1024 + lane * 16); x[4 * q] = v[0]; x[4 * q + 1] = v[1]; x[4 * q + 2] = v[2]; x[4 * q + 3] = v[3]; }
    return x; }
__device__ __forceinline__ void cm_to_lc(f32x16 (&C)[2][2], float (&lc)[64]) {
    asm volatile("s_nop 15\n\ts_nop 15" : "+v"(C[0][0]), "+v"(C[0][1]), "+v"(C[1][0]), "+v"(C[1][1]));
#pragma unroll
    for (int tm = 0; tm < 2; ++tm)
#pragma unroll
        for (int r = 0; r < 16; ++r) { float a = C[tm][0][r], b = C[tm][1][r]; swap32f(a, b); lc[32 * tm + crow(r, 0)] = a; lc[32 * tm + crow(r, 1)] = b; }
}
__device__ __forceinline__ void lc16_to_frags(const float (&v)[16], frag& f0, frag& f1) {
    unsigned X[4], Y[4];
#pragma unroll
    for (int i = 0; i < 4; ++i) { const int j0 = 2 * i, j1 = 2 * i + 1; const int t0 = (j0 & 3) + 8 * (j0 >> 2), t1 = (j1 & 3) + 8 * (j1 >> 2);
        X[i] = cvt_pk_bf16(v[t0], v[t1]); Y[i] = cvt_pk_bf16(v[t0 + 4], v[t1 + 4]); swap32(X[i], Y[i]); }
    f0 = mkfrag(X[0], X[1], X[2], X[3]); f1 = mkfrag(Y[0], Y[1], Y[2], Y[3]);
}
__device__ __forceinline__ void lc_to_frags(const float (&lc)[64], frag (&out)[4][2]) {
#pragma unroll
    for (int s = 0; s < 4; ++s) { float v[16];
#pragma unroll
        for (int i = 0; i < 16; ++i) v[i] = lc[16 * s + i];
        lc16_to_frags(v, out[s][0], out[s][1]); }
}
__device__ __forceinline__ void shift8(const bf16_t* PRW, int row, bool hasprev, int col, const float* mu, float (&x)[8]) {
    f32x4 c0, c1, p0, p1; unpack8(*(const u32x4*)(PRW + (size_t)row * 1792 + col), c0, c1);
    if (hasprev) unpack8(*(const u32x4*)(PRW + (size_t)(row - 1) * 1792 + col), p0, p1); else { p0 = (f32x4){0.f, 0.f, 0.f, 0.f}; p1 = p0; }
    const f32x4 m0 = *(const f32x4*)(mu + col), m1 = *(const f32x4*)(mu + col + 4);
    const f32x4 y0 = c0 + (p0 - c0) * m0, y1 = c1 + (p1 - c1) * m1;
#pragma unroll
    for (int i = 0; i < 4; ++i) { x[i] = y0[i]; x[4 + i] = y1[i]; }
}
template <class T> __device__ __forceinline__ T* launder(T* q) { asm volatile("" : "+s"(q)); return q; }
__device__ __forceinline__ frag colfrag(const float* W, int ldw, int k0, int col) {
    float v[8];
#pragma unroll
    for (int j = 0; j < 8; ++j) v[j] = W[(size_t)(k0 + j) * ldw + col];
    return mkfrag(cvt_pk_bf16(v[0], v[1]), cvt_pk_bf16(v[2], v[3]), cvt_pk_bf16(v[4], v[5]), cvt_pk_bf16(v[6], v[7]));
}

__device__ __forceinline__ void r1_cell(const Params& p, int chunk, int h, LAS unsigned char* lds, int lane) {
    asm volatile("" : "+v"(lane));
    unsigned char* ws = launder(p.ws); const bf16_t* PRW = (const bf16_t*)(ws + WS_PRW); const float* mu = launder(p.in[16]);
    const float* wd2 = launder(p.in[18]); const float* a2w = launder(p.in[20]);
    int l31 = lane & 31, hi = lane >> 5; const int row0 = chunk * 64, c = h * 64 + lane; const bool first = (row0 % SEQ) == 0;
    const int cell = chunk * 8 + h;
    GAS unsigned char* cs = (GAS unsigned char*)(ws + WS_RW + (size_t)cell * CELL);
    const f32x16 Z = {};
    float wl[64], al[64];
    { f32x16 CW[2][2], CA[2][2];
#pragma unroll
      for (int i = 0; i < 2; ++i)
#pragma unroll
          for (int j = 0; j < 2; ++j) { CW[i][j] = Z; CA[i][j] = Z; }
#pragma unroll
      for (int s = 0; s < 4; ++s) { frag Aw[2], Aa[2];
#pragma unroll
          for (int tm = 0; tm < 2; ++tm) { const int tl = 32 * tm + l31, row = row0 + tl; const bool hp = !(first && tl == 0); float x[8];
              shift8(PRW, row, hp, 1536 + 16 * s + 8 * hi, mu, x);
              Aw[tm] = mkfrag(cvt_pk_bf16(tanhf(x[0]), tanhf(x[1])), cvt_pk_bf16(tanhf(x[2]), tanhf(x[3])), cvt_pk_bf16(tanhf(x[4]), tanhf(x[5])), cvt_pk_bf16(tanhf(x[6]), tanhf(x[7])));
              shift8(PRW, row, hp, 1600 + 16 * s + 8 * hi, mu, x);
              Aa[tm] = mkfrag(cvt_pk_bf16(x[0], x[1]), cvt_pk_bf16(x[2], x[3]), cvt_pk_bf16(x[4], x[5]), cvt_pk_bf16(x[6], x[7])); }
#pragma unroll
          for (int tn = 0; tn < 2; ++tn) { const frag Bw = colfrag(wd2, 512, 16 * s + 8 * hi, h * 64 + 32 * tn + l31), Ba = colfrag(a2w, 512, 16 * s + 8 * hi, h * 64 + 32 * tn + l31);
#pragma unroll
              for (int tm = 0; tm < 2; ++tm) { CW[tm][tn] = mma(Aw[tm], Bw, CW[tm][tn]); CA[tm][tn] = mma(Aa[tm], Ba, CA[tm][tn]); } } }
      cm_to_lc(CW, wl); cm_to_lc(CA, al); }
    { const float w0 = p.in[17][c]; float cl = 0.f;
#pragma unroll
      for (int t = 0; t < 64; ++t) { const float u = -(w0 + wl[t]); const float sp = u > 20.f ? u : log1pf(__expf(u)); cl -= __expf(-sp - 0.5f); wl[t] = cl; } }
    const float DL = __expf(wl[63]);
    { const float a0c = p.in[19][c], kkc = p.in[22][c], kac = p.in[23][c], rkc = p.in[24][c], mur = mu[c], muk = mu[512 + c], muv = mu[1024 + c];
      float pr = 0.f, pk = 0.f, pvv = 0.f, bon = 0.f;
      if (!first) { const bf16_t* q = PRW + (size_t)(row0 - 1) * 1792 + c; pr = bf2f(q[0]); pk = bf2f(q[512]); pvv = bf2f(q[1024]); }
      GAS bf16_t* SKKe = (GAS bf16_t*)(cs + S_KKE); GAS bf16_t* SRd = (GAS bf16_t*)(cs + S_RD); GAS bf16_t* SBi = (GAS bf16_t*)(cs + S_BI); GAS bf16_t* SKi = (GAS bf16_t*)(cs + S_KI);
#pragma unroll
      for (int s = 0; s < 4; ++s) { float bi16[16], ki16[16], v16[16];
#pragma unroll
          for (int tt = 0; tt < 16; ++tt) { const int t = 16 * s + tt; const bf16_t* q = PRW + (size_t)(row0 + t) * 1792 + c;
              const float cr = bf2f(q[0]), ck = bf2f(q[512]), cv = bf2f(q[1024]);
              const float xr = cr + (pr - cr) * mur, xk = ck + (pk - ck) * muk, xv = cv + (pvv - cv) * muv; pr = cr; pk = ck; pvv = cv;
              const float a = sigmoidf_(a0c + al[t]);
              const float Dt = __expf(wl[t]), Et = t == 0 ? 1.f : __expf(wl[t > 0 ? t - 1 : 0]), iD = __expf(-wl[t]);
              const float kkv = xk * kkc; const float ss = wave_sum(kkv * kkv); const float kkn = kkv / fmaxf(sqrtf(ss), 1e-12f);
              const float kmod = xk * (1.f + (a - 1.f) * kac), bb = kkn * a;
              const float bs = wave_sum(xr * kmod * rkc); if (lane == t) bon = bs;
              const float kket = kkn * Et, rd = xr * Dt, bi = bb * iD, ki = kmod * iD;
              SKKe[t * 64 + lane] = (bf16_t)f2bf(kket); SRd[t * 64 + lane] = (bf16_t)f2bf(rd); SBi[t * 64 + lane] = (bf16_t)f2bf(bi); SKi[t * 64 + lane] = (bf16_t)f2bf(ki);
              bi16[tt] = bi; ki16[tt] = ki; v16[tt] = xv; asm volatile("" ::: "memory"); __builtin_amdgcn_sched_barrier(0); }
          frag f0, f1;
          lc16_to_frags(bi16, f0, f1); dump_frag(cs + F_BIB, 2 * s, lane, f0); dump_frag(cs + F_BIB, 2 * s + 1, lane, f1);
          lc16_to_frags(ki16, f0, f1); dump_frag(cs + F_KIB, 2 * s, lane, f0); dump_frag(cs + F_KIB, 2 * s + 1, lane, f1);
          lc16_to_frags(v16, f0, f1); dump_frag(cs + F_VB, 2 * s, lane, f0); dump_frag(cs + F_VB, 2 * s + 1, lane, f1); }
      ((GAS float*)(ws + WS_BON))[cell * 64 + lane] = bon; }
    asm volatile("s_waitcnt vmcnt(0) lgkmcnt(0)" ::: "memory");
#define RK_FENCE() do { asm volatile("" ::: "memory"); __builtin_amdgcn_sched_barrier(0); } while (0)
    float x2[64];
    { frag KiF[2][4], KKeF[2][4];
      { frag BiF[2][4];
        load_rm((const GAS bf16_t*)(cs + S_KKE), lane, KKeF); load_rm((const GAS bf16_t*)(cs + S_BI), lane, BiF);
        frag RdF[2][4]; load_rm((const GAS bf16_t*)(cs + S_RD), lane, RdF);
#pragma unroll
        for (int tmi = 0; tmi < 2; ++tmi)
#pragma unroll
            for (int tnt = tmi; tnt < 2; ++tnt) { f32x16 a = Z;
#pragma unroll
                for (int s = 0; s < 4; ++s) a = mma(BiF[tmi][s], RdF[tnt][s], a);
                if (tmi == tnt) {
#pragma unroll
                    for (int r = 0; r < 16; ++r) a[r] = crow(r, hi) <= l31 ? a[r] : 0.f; }
                dump_frag(cs + F_ARBA, (2 * tmi) * 2 + tnt, lane, pack_half(a, 0)); dump_frag(cs + F_ARBA, (2 * tmi + 1) * 2 + tnt, lane, pack_half(a, 1)); }
        RK_FENCE();
        load_rm((const GAS bf16_t*)(cs + S_KI), lane, KiF);
#pragma unroll
        for (int tmi = 0; tmi < 2; ++tmi)
#pragma unroll
            for (int tnt = tmi; tnt < 2; ++tnt) { f32x16 a = Z;
#pragma unroll
                for (int s = 0; s < 4; ++s) a = mma(KiF[tmi][s], RdF[tnt][s], a);
                if (tmi == tnt) {
#pragma unroll
                    for (int r = 0; r < 16; ++r) a[r] = crow(r, hi) <= l31 ? a[r] : 0.f; }
                dump_frag(cs + F_ARKA, (2 * tmi) * 2 + tnt, lane, pack_half(a, 0)); dump_frag(cs + F_ARKA, (2 * tmi + 1) * 2 + tnt, lane, pack_half(a, 1)); }
        RK_FENCE(); }
      frag NmA[2][4];
#pragma unroll
      for (int tmi = 0; tmi < 2; ++tmi)
#pragma unroll
          for (int tnt = tmi; tnt < 2; ++tnt) { f32x16 a = Z;
#pragma unroll
              for (int s = 0; s < 4; ++s) a = mma(KiF[tmi][s], KKeF[tnt][s], a);
              if (tmi == tnt) {
#pragma unroll
                  for (int r = 0; r < 16; ++r) a[r] = crow(r, hi) < l31 ? a[r] : 0.f; }
              NmA[tnt][2 * tmi] = pack_half(a, 0); NmA[tnt][2 * tmi + 1] = pack_half(a, 1); }
      RK_FENCE();
      { f32x16 NV[2][2];
#pragma unroll
        for (int tn = 0; tn < 2; ++tn) { NV[0][tn] = Z; NV[1][tn] = Z;
#pragma unroll
            for (int ks = 0; ks < 4; ++ks) { const frag vb = load_frag(cs + F_VB, 2 * ks + tn, lane);
                if (ks < 2) NV[0][tn] = mma(NmA[0][ks], vb, NV[0][tn]);
                NV[1][tn] = mma(NmA[1][ks], vb, NV[1][tn]); } }
        cm_to_lc(NV, x2);
#pragma unroll
        for (int t = 0; t < 64; ++t) x2[t] = -x2[t]; } }
    asm volatile("s_waitcnt vmcnt(0) lgkmcnt(0)" ::: "memory");
    RK_FENCE();
    f32x2 xs[64];
    { const GAS bf16_t* SKKe = (const GAS bf16_t*)(cs + S_KKE);
#pragma unroll
      for (int t = 0; t < 64; ++t) { xs[t].x = bf2f(SKKe[t * 64 + lane]); xs[t].y = x2[t]; } }
    RK_FENCE();
#pragma unroll
    for (int tm = 0; tm < 2; ++tm) { float Mh[32];
        { f32x16 c0 = Z, c1 = Z;
#pragma unroll
          for (int s = 0; s < 4; ++s) { const frag ka = *(const GAS frag*)((const GAS bf16_t*)(cs + S_KKE) + (32 * tm + l31) * 64 + 16 * s + 8 * hi);
              const frag b0 = *(const GAS frag*)((const GAS bf16_t*)(cs + S_BI) + l31 * 64 + 16 * s + 8 * hi);
              c0 = mma(ka, b0, c0);
              if (tm == 1) { const frag b1 = *(const GAS frag*)((const GAS bf16_t*)(cs + S_BI) + (32 + l31) * 64 + 16 * s + 8 * hi); c1 = mma(ka, b1, c1); } }
          asm volatile("s_nop 15\n\ts_nop 15" : "+v"(c0), "+v"(c1));
#pragma unroll
          for (int r = 0; r < 16; ++r) { float a = c0[r], b = c1[r]; swap32f(a, b); Mh[crow(r, 0)] = a; Mh[crow(r, 1)] = b; } }
        RK_FENCE();
#pragma unroll
        for (int tl = 0; tl < 32; ++tl) { const int t = 32 * tm + tl; if (t == 0) continue; f32x2 sacc = {0.f, 0.f};
#pragma unroll
            for (int i = 0; i < t; ++i) { const float m = __uint_as_float((unsigned)__builtin_amdgcn_readlane((int)__float_as_uint(Mh[tl]), i)); sacc += xs[i] * m;
                if ((i & 15) == 15) RK_FENCE(); }
            xs[t] -= sacc; RK_FENCE(); } }
    float kke[64];
#pragma unroll
    for (int t = 0; t < 64; ++t) { kke[t] = xs[t].x; x2[t] = xs[t].y; }
    asm volatile("" : "+v"(lane)); cs = launder(cs); l31 = lane & 31; hi = lane >> 5;
    frag WB[4][2], U0B[4][2]; lc_to_frags(kke, WB); lc_to_frags(x2, U0B);
    RK_FENCE();
    { f32x16 QT[2][2];
      { frag BiB[4][2];
#pragma unroll
        for (int ks = 0; ks < 4; ++ks) { BiB[ks][0] = load_frag(cs + F_BIB, 2 * ks, lane); BiB[ks][1] = load_frag(cs + F_BIB, 2 * ks + 1, lane); }
#pragma unroll
        for (int tm = 0; tm < 2; ++tm)
#pragma unroll
            for (int tn = 0; tn < 2; ++tn) { f32x16 a = Z;
#pragma unroll
                for (int ks = 0; ks < 4; ++ks) a = mma(WB[ks][tm], BiB[ks][tn], a);
                const float dlc = __shfl(DL, 32 * tn + l31);
#pragma unroll
                for (int r = 0; r < 16; ++r) a[r] = ((tm == tn && crow(r, hi) == l31 ? 1.f : 0.f) - a[r]) * dlc;
                dump_frag(cs + O_P, (2 * tm) * 2 + tn, lane, pack_half(a, 0)); dump_frag(cs + O_P, (2 * tm + 1) * 2 + tn, lane, pack_half(a, 1)); RK_FENCE(); }
#pragma unroll
        for (int tm = 0; tm < 2; ++tm)
#pragma unroll
            for (int tn = 0; tn < 2; ++tn) { QT[tm][tn] = Z;
#pragma unroll
                for (int ks = 0; ks < 4; ++ks) QT[tm][tn] = mma(BiB[ks][tm], U0B[ks][tn], QT[tm][tn]); }
        RK_FENCE(); }
#pragma unroll
      for (int ks = 0; ks < 4; ++ks) { frag kib[2], vb[2];
#pragma unroll
          for (int t2 = 0; t2 < 2; ++t2) { kib[t2] = load_frag(cs + F_KIB, 2 * ks + t2, lane); vb[t2] = load_frag(cs + F_VB, 2 * ks + t2, lane); }
#pragma unroll
          for (int tm = 0; tm < 2; ++tm)
#pragma unroll
              for (int tn = 0; tn < 2; ++tn) QT[tm][tn] = mma(kib[tm], vb[tn], QT[tm][tn]);
          RK_FENCE(); }
#pragma unroll
      for (int tm = 0; tm < 2; ++tm)
#pragma unroll
          for (int tn = 0; tn < 2; ++tn) {
#pragma unroll
              for (int r = 0; r < 16; ++r) { const float d0 = __uint_as_float((unsigned)__builtin_amdgcn_readlane((int)__float_as_uint(DL), 32 * tm + crow(r, 0))), d1 = __uint_as_float((unsigned)__builtin_amdgcn_readlane((int)__float_as_uint(DL), 32 * tm + crow(r, 1)));
                  QT[tm][tn][r] *= hi ? d1 : d0; }
              dump_tile_f32(cs + O_QT, tm * 2 + tn, lane, QT[tm][tn]); }
      RK_FENCE(); }
#pragma unroll
    for (int mt = 0; mt < 2; ++mt) { f32x16 a0 = Z, a1 = Z;
#pragma unroll
        for (int ks = 0; ks < 4; ++ks) if (mt == 1 || ks < 2) { const frag arb = load_frag(cs + F_ARBA, ks * 2 + mt, lane), ark = load_frag(cs + F_ARKA, ks * 2 + mt, lane);
            const frag v0 = load_frag(cs + F_VB, 2 * ks, lane), v1 = load_frag(cs + F_VB, 2 * ks + 1, lane);
            a0 = mma(arb, U0B[ks][0], a0); a0 = mma(ark, v0, a0); a1 = mma(arb, U0B[ks][1], a1); a1 = mma(ark, v1, a1); }
        dump_tile_f32(cs + O_Y0, mt * 2, lane, a0); dump_tile_f32(cs + O_Y0, mt * 2 + 1, lane, a1); RK_FENCE(); }
    { const GAS bf16_t* SRd = (const GAS bf16_t*)(cs + S_RD);
#pragma unroll
      for (int tn = 0; tn < 2; ++tn) { f32x16 a[2] = {Z, Z};
#pragma unroll
          for (int ks = 0; ks < 4; ++ks) if (tn == 1 || ks < 2) { const frag arb = load_frag(cs + F_ARBA, ks * 2 + tn, lane); a[0] = mma(WB[ks][0], arb, a[0]); a[1] = mma(WB[ks][1], arb, a[1]); }
#pragma unroll
          for (int tm = 0; tm < 2; ++tm) {
#pragma unroll
              for (int q = 0; q < 4; ++q) { const u32x2 w = *(const GAS u32x2*)(SRd + (32 * tn + l31) * 64 + 32 * tm + 8 * q + 4 * hi);
                  a[tm][4 * q] = bf2f(w.x & 0xffffu) - a[tm][4 * q]; a[tm][4 * q + 1] = bf2f(w.x >> 16) - a[tm][4 * q + 1]; a[tm][4 * q + 2] = bf2f(w.y & 0xffffu) - a[tm][4 * q + 2]; a[tm][4 * q + 3] = bf2f(w.y >> 16) - a[tm][4 * q + 3]; }
              dump_frag(cs + O_GA, (2 * tm) * 2 + tn, lane, pack_half(a[tm], 0)); dump_frag(cs + O_GA, (2 * tm + 1) * 2 + tn, lane, pack_half(a[tm], 1)); }
          RK_FENCE(); } }
#undef RK_FENCE
}

__device__ __forceinline__ void r2_chain(const Params& p, int bh, int lane) {
    unsigned char* ws = p.ws; const int b = bh >> 3, h = bh & 7;
    f32x16 S[2][2];
#pragma unroll
    for (int i = 0; i < 2; ++i)
#pragma unroll
        for (int j = 0; j < 2; ++j) S[i][j] = f32x16{};
    frag PA[4][2]; f32x16 QT[2][2];
    { const GAS unsigned char* cs = (const GAS unsigned char*)(ws + WS_RW + (size_t)((b * 64) * 8 + h) * CELL);
#pragma unroll
      for (int ks = 0; ks < 4; ++ks) { PA[ks][0] = load_frag(cs + O_P, ks * 2, lane); PA[ks][1] = load_frag(cs + O_P, ks * 2 + 1, lane); }
#pragma unroll
      for (int t = 0; t < 4; ++t) QT[t >> 1][t & 1] = load_tile_f32(cs + O_QT, t, lane); }
#pragma nounroll
    for (int cidx = 0; cidx < 64; ++cidx) {
        GAS unsigned char* cs = (GAS unsigned char*)(ws + WS_RW + (size_t)((b * 64 + cidx) * 8 + h) * CELL);
        const GAS unsigned char* cn = (const GAS unsigned char*)(ws + WS_RW + (size_t)((b * 64 + (cidx < 63 ? cidx + 1 : cidx)) * 8 + h) * CELL);
        frag SB[4][2];
#pragma unroll
        for (int tm = 0; tm < 2; ++tm)
#pragma unroll
            for (int tn = 0; tn < 2; ++tn) { SB[2 * tm][tn] = pack_half(S[tm][tn], 0); SB[2 * tm + 1][tn] = pack_half(S[tm][tn], 1); }
#pragma unroll
        for (int ks = 0; ks < 4; ++ks) { dump_frag(cs + O_S0B, ks * 2, lane, SB[ks][0]); dump_frag(cs + O_S0B, ks * 2 + 1, lane, SB[ks][1]); }
        frag PN[4][2]; f32x16 QN[2][2];
#pragma unroll
        for (int ks = 0; ks < 4; ++ks) { PN[ks][0] = load_frag(cn + O_P, ks * 2, lane); PN[ks][1] = load_frag(cn + O_P, ks * 2 + 1, lane); }
#pragma unroll
        for (int t = 0; t < 4; ++t) QN[t >> 1][t & 1] = load_tile_f32(cn + O_QT, t, lane);
#pragma unroll
        for (int tm = 0; tm < 2; ++tm)
#pragma unroll
            for (int tn = 0; tn < 2; ++tn) { f32x16 a = QT[tm][tn];
#pragma unroll
                for (int ks = 0; ks < 4; ++ks) a = mma(PA[ks][tm], SB[ks][tn], a);
                S[tm][tn] = a; }
#pragma unroll
        for (int ks = 0; ks < 4; ++ks) { PA[ks][0] = PN[ks][0]; PA[ks][1] = PN[ks][1]; }
#pragma unroll
        for (int t = 0; t < 4; ++t) QT[t >> 1][t & 1] = QN[t >> 1][t & 1];
    }
}

__device__ __forceinline__ void r3_cell(const Params& p, int chunk, int h, int lane) {
    asm volatile("" : "+v"(lane));
    unsigned char* ws = launder(p.ws); const bf16_t* PRW = (const bf16_t*)(ws + WS_PRW); const float* mu = launder(p.in[16]); const float* g2w = launder(p.in[21]);
    const int l31 = lane & 31, hi = lane >> 5, row0 = chunk * 64; const bool first = (row0 % SEQ) == 0; const int cell = chunk * 8 + h;
    const GAS unsigned char* cs = (const GAS unsigned char*)(ws + WS_RW + (size_t)cell * CELL);
    f32x16 Y[2][2];
    { frag GA[4][2], SB[4][2];
#pragma unroll
      for (int ks = 0; ks < 4; ++ks) { GA[ks][0] = load_frag(cs + O_GA, ks * 2, lane); GA[ks][1] = load_frag(cs + O_GA, ks * 2 + 1, lane); SB[ks][0] = load_frag(cs + O_S0B, ks * 2, lane); SB[ks][1] = load_frag(cs + O_S0B, ks * 2 + 1, lane); }
#pragma unroll
      for (int tm = 0; tm < 2; ++tm)
#pragma unroll
          for (int tn = 0; tn < 2; ++tn) { f32x16 a = load_tile_f32(cs + O_Y0, tm * 2 + tn, lane);
#pragma unroll
              for (int ks = 0; ks < 4; ++ks) a = mma(GA[ks][tm], SB[ks][tn], a);
              Y[tm][tn] = a; } }
    f32x16 Gt[2][2];
#pragma unroll
    for (int i = 0; i < 2; ++i)
#pragma unroll
        for (int j = 0; j < 2; ++j) Gt[i][j] = f32x16{};
#pragma unroll
    for (int s = 0; s < 8; ++s) { frag Ag[2];
#pragma unroll
        for (int tm = 0; tm < 2; ++tm) { const int tl = 32 * tm + l31; float x[8]; shift8(PRW, row0 + tl, !(first && tl == 0), 1664 + 16 * s + 8 * hi, mu, x);
            Ag[tm] = mkfrag(cvt_pk_bf16(sigmoidf_(x[0]), sigmoidf_(x[1])), cvt_pk_bf16(sigmoidf_(x[2]), sigmoidf_(x[3])), cvt_pk_bf16(sigmoidf_(x[4]), sigmoidf_(x[5])), cvt_pk_bf16(sigmoidf_(x[6]), sigmoidf_(x[7]))); }
#pragma unroll
        for (int tn = 0; tn < 2; ++tn) { const frag Bg = colfrag(g2w, 512, 16 * s + 8 * hi, h * 64 + 32 * tn + l31);
#pragma unroll
            for (int tm = 0; tm < 2; ++tm) Gt[tm][tn] = mma(Ag[tm], Bg, Gt[tm][tn]); } }
    bf16_t* ACAT = (bf16_t*)(ws + WS_ACAT); const GAS float* BON = (const GAS float*)(ws + WS_BON) + cell * 64;
    float lw[2], lb[2];
#pragma unroll
    for (int tn = 0; tn < 2; ++tn) { lw[tn] = p.in[25][h * 64 + 32 * tn + l31]; lb[tn] = p.in[26][h * 64 + 32 * tn + l31]; }
#pragma unroll
    for (int tm = 0; tm < 2; ++tm) { frag VB[2][2];
#pragma unroll
        for (int half = 0; half < 2; ++half)
#pragma unroll
            for (int tn = 0; tn < 2; ++tn) VB[half][tn] = load_frag(cs + F_VB, (2 * tm + half) * 2 + tn, lane);
#pragma unroll
        for (int r = 0; r < 16; ++r) { const int t = 32 * tm + crow(r, hi);
            float s = Y[tm][0][r] + Y[tm][1][r];
#pragma unroll
            for (int off = 1; off < 32; off <<= 1) s += __shfl_xor(s, off);
            const float mean = s * (1.f / 64.f); const float d0 = Y[tm][0][r] - mean, d1 = Y[tm][1][r] - mean; float q = d0 * d0 + d1 * d1;
#pragma unroll
            for (int off = 1; off < 32; off <<= 1) q += __shfl_xor(q, off);
            const float rs = 1.f / sqrtf(q * (1.f / 64.f) + 64e-5f), bon = BON[t];
#pragma unroll
            for (int tn = 0; tn < 2; ++tn) { const unsigned short vb = (unsigned short)VB[r >> 3][tn][r & 7]; const float v = bf2f((unsigned)vb);
                const float yn = (tn ? d1 : d0) * rs * lw[tn] + lb[tn];
#if defined(RK_PROBE) && !defined(RK_PROBE_SWAP)
                ((bf16_t*)(ws + WS_ACAT2))[(size_t)(row0 + t) * 512 + h * 64 + 32 * tn + l31] = (bf16_t)f2bf((yn + bon * v) * Gt[tm][tn][r]); } } }
#else
                ACAT[(size_t)(row0 + t) * 1024 + 512 + h * 64 + 32 * tn + l31] = (bf16_t)f2bf((yn + bon * v) * Gt[tm][tn][r]); } } }
#endif
}
}
__device__ __forceinline__ void phase_topk(const Params& p, int G, int wave, int lane) {
    unsigned char* ws = p.ws; const float* LOGIT = (const float*)(ws + WS_LOGIT); const float* rb = p.in[32];
    unsigned* CNT = (unsigned*)(ws + WS_CTL) + CW_CNT; int* ROWMAP = (int*)(ws + WS_ROWMAP); float* ROWW = (float*)(ws + WS_ROWW);
    const float NEG = -INFINITY; const f32x4 rb4 = *(const f32x4*)(rb + 4 * lane);
    for (int row = blockIdx.x * 8 + wave; row < M; row += G * 8) {
        const f32x4 l4 = *(const f32x4*)(LOGIT + (size_t)row * 256 + 4 * lane);
        float sc[4], cand[4];
#pragma unroll
        for (int j = 0; j < 4; ++j) { sc[j] = sigmoidf_(l4[j]); cand[j] = sc[j] + rb4[j]; }
        float m1, m2; { const float a = fmaxf(cand[0], cand[1]), c2 = fminf(cand[0], cand[1]), d = fmaxf(cand[2], cand[3]), e2 = fminf(cand[2], cand[3]); m1 = fmaxf(a, d); m2 = fmaxf(fminf(a, d), fmaxf(c2, e2)); }
#pragma unroll
        for (int off = 1; off < 8; off <<= 1) { const float o1 = __shfl_xor(m1, off), o2 = __shfl_xor(m2, off); const float n1 = fmaxf(m1, o1), n2 = fmaxf(fminf(m1, o1), fmaxf(m2, o2)); m1 = n1; m2 = n2; }
        const float gs = m1 + m2; const int g = lane >> 3; int rank = 0;
#pragma unroll
        for (int gg = 0; gg < 8; ++gg) { const float og = __shfl(gs, gg * 8); rank += (og > gs || (og == gs && gg < g)) ? 1 : 0; }
        if (rank >= 4) {
#pragma unroll
            for (int j = 0; j < 4; ++j) cand[j] = NEG; }
        int myE = 0; float myS = 0.f, ssum = 0.f;
#pragma unroll
        for (int k = 0; k < 8; ++k) {
            float bv = cand[0]; int bi = 4 * lane;
#pragma unroll
            for (int j = 1; j < 4; ++j) if (cand[j] > bv) { bv = cand[j]; bi = 4 * lane + j; }
#pragma unroll
            for (int off = 1; off < 64; off <<= 1) { const float ov = __shfl_xor(bv, off); const int oi = __shfl_xor(bi, off); if (ov > bv || (ov == bv && oi < bi)) { bv = ov; bi = oi; } }
            const int owner = bi >> 2, jj = bi & 3;
            const float mine = jj == 0 ? sc[0] : jj == 1 ? sc[1] : jj == 2 ? sc[2] : sc[3];
            const float sk = __shfl(mine, owner);
            if (lane == owner) {
#pragma unroll
                for (int j = 0; j < 4; ++j) if (j == jj) cand[j] = NEG; }
            ssum += sk; if (lane == k) { myE = bi; myS = sk; }
        }
        if (lane < 8) { const float w = myS / ssum * 2.5f; const unsigned pos = __hip_atomic_fetch_add(CNT + myE, 1u, RLX_AGENT);
            ROWMAP[myE * CAP + pos] = row * 16 + lane; ROWW[myE * CAP + pos] = w; }
    }
}
__device__ __forceinline__ void phase_combine(const Params& p, int G, int tid) {
    unsigned char* ws = p.ws; const float* X1 = (const float*)(ws + WS_X1); const float* MODF = (const float*)(ws + WS_MODF); const bf16_t* YS = (const bf16_t*)(ws + WS_YS);
    for (int idx = blockIdx.x * 512 + tid; idx < M * 128; idx += G * 512) { const int row = idx >> 7, col = (idx & 127) * 8, b = row / SEQ;
        f32x4 a0 = {0.f, 0.f, 0.f, 0.f}, a1 = {0.f, 0.f, 0.f, 0.f};
#pragma unroll
        for (int s = 0; s < 9; ++s) { f32x4 t0, t1; unpack8(*(const u32x4*)(YS + ((size_t)row * 9 + s) * 1024 + col), t0, t1); a0 += t0; a1 += t1; }
        const f32x4 g0 = *(const f32x4*)(MODF + b * 6144 + 5120 + col), g1 = *(const f32x4*)(MODF + b * 6144 + 5120 + col + 4);
        const size_t o = (size_t)row * D + col;
#ifdef RK_PROBE
#ifdef PROBE_STAT
        { const unsigned cks = ((const unsigned*)(ws + WS_CTL))[CW_PROBE + 4]; const float pert = 1.f + 0.03f * (float)(cks & 0xffffu) * (1.f / 65536.f);
#else
        { const float* acc = (const float*)(ws + WS_CTL) + CW_PROBE; const float pert = 1.f + (acc[2] > 0.f ? 100.f : 10.f * sqrtf(acc[0] / acc[1]));
#endif
          *(f32x4*)(p.out + o) = (*(const f32x4*)(X1 + o) + g0 * a0) * pert; *(f32x4*)(p.out + o + 4) = (*(const f32x4*)(X1 + o + 4) + g1 * a1) * pert; } }
#else
        *(f32x4*)(p.out + o) = *(const f32x4*)(X1 + o) + g0 * a0; *(f32x4*)(p.out + o + 4) = *(const f32x4*)(X1 + o + 4) + g1 * a1; }
#endif
}

__global__ void __launch_bounds__(512, 2) hybrid_fwd(Params p) {
    extern __shared__ __attribute__((aligned(16))) unsigned char lds_raw[];
    LAS unsigned char* lds = (LAS unsigned char*)lds_raw;
    const int tid = threadIdx.x, lane = tid & 63, wave = __builtin_amdgcn_readfirstlane(tid >> 6), G = gridDim.x;
    unsigned char* ws = p.ws; unsigned* ctl = (unsigned*)(ws + WS_CTL);
    for (int u = tid; u < (LDS_BYTES - LDSCTL_OFF) / 4; u += 512) ((LAS unsigned*)(lds + LDSCTL_OFF))[u] = 0u;
    __syncthreads();
    XcdBarrier bar; bar.bar = ctl + CW_BAR; bar.x = 0; bar.st = nullptr;
    if (MK_ONE_LAUNCH) bar = xcd_barrier_post(ctl + CW_BAR, (volatile LAS unsigned*)(lds + MISC_OFF) + 8);
    const int lo = p.ph_lo, hi = p.ph_hi;
#define IN(k) (lo <= (k) && (k) < hi)
#define SEAM(k) do { if (MK_ONE_LAUNCH && IN(k) && IN((k) + 1)) xcd_barrier(bar); } while (0)

    if (IN(0)) { phase_prologue(p, lds, G, wave, lane); } SEAM(0);
    if (IN(1)) { phase_norm1(p, lds, G, tid, wave, lane); } SEAM(1);
    if (IN(2)) {
        pg8::PlainOrder S; S.init(ws + WS_XN, ws + WS_W1T, M, N1, 1024, 1024, G, (int)blockIdx.x);
        EpiG1 E{ws, p.in[9], p.in[10], (const float*)(ws + WS_COS), (const float*)(ws + WS_SIN), p.in[8]};
        pg8::gemm_phase<EpiG1, pg8::PlainOrder, true, false>(lds, 1024, 1024, 1024, S, E);
    } SEAM(2);
    if (IN(3)) {
        for (int chunk = blockIdx.x; chunk < M / 64; chunk += G) rk::r1_cell(p, chunk, wave, lds, lane);
#ifdef RK_PROBE
        for (int un = blockIdx.x; un < M / 32; un += G) rwkv_prep_unit(p, un, lds, tid);
#endif
        const float lam = ((const float*)(ws + WS_SCAL))[0];
        for (int pi = blockIdx.x; pi < 256; pi += G) { const int bh = pi >> 4, s = pi & 15;
            att::attn_unit(bh >> 2, bh & 3, s, (const bf16_t*)(ws + WS_QN), (const bf16_t*)(ws + WS_KN), (const bf16_t*)(ws + WS_VB), (bf16_t*)(ws + WS_ACAT), p.in[15], lam, lds);
            att::attn_unit(bh >> 2, bh & 3, 31 - s, (const bf16_t*)(ws + WS_QN), (const bf16_t*)(ws + WS_KN), (const bf16_t*)(ws + WS_VB), (bf16_t*)(ws + WS_ACAT), p.in[15], lam, lds); }
    } SEAM(3);
    if (IN(4)) { if (blockIdx.x < 32 && wave == 0) rk::r2_chain(p, (int)blockIdx.x, lane);
#ifdef RK_PROBE
        if (blockIdx.x >= 32 && blockIdx.x < 48) rwkv_scan_v1(p, lds, tid, wave, lane);
#endif
    } SEAM(4);
    if (IN(5)) { for (int chunk = blockIdx.x; chunk < M / 64; chunk += G) rk::r3_cell(p, chunk, wave, lane);
#ifdef RK_PROBE
        rwkv_post(p, G, wave, lane);
#endif
    } SEAM(5);
    if (IN(6)) {
#ifdef RK_PROBE
        probe_compare(p, G, tid);
#ifdef PROBE_STAT
        probe_checksum(p, G, tid);
#endif
#endif
        BranchOrder S{(const char*)(ws + WS_ACAT), (const char*)(ws + WS_WAT), (const char*)(ws + WS_WBT), G, (int)blockIdx.x};
        EpiBranch E{(const bf16_t*)(ws + WS_GATE), (float*)(ws + WS_MIXF), (bf16_t*)(ws + WS_MIX)};
        pg8::gemm_phase<EpiBranch, BranchOrder, true, false>(lds, 512, 1024, 512, S, E);
    } SEAM(6);
    if (IN(7)) {
        pg8::PlainOrder S; S.init(ws + WS_MIX, ws + WS_WOT, M, 1024, 1024, 1024, G, (int)blockIdx.x);
        EpiOut E{p.in[0], (const float*)(ws + WS_MODF), (float*)(ws + WS_X1)};
        pg8::gemm_phase<EpiOut, pg8::PlainOrder, true, false>(lds, 1024, 1024, 1024, S, E);
    } SEAM(7);
    if (IN(8)) { phase_norm2(p, lds, G, tid, wave, lane); } SEAM(8);
    if (IN(9)) {
        pg8::PlainOrder S; S.init(ws + WS_H2, ws + WS_WRT, M, 256, 3072, 3072, G, (int)blockIdx.x);
        EpiF32 E{(float*)(ws + WS_LOGIT), 256};
        pg8::gemm_phase<EpiF32, pg8::PlainOrder, true, false>(lds, 3072, 3072, 3072, S, E);
    } SEAM(9);
    if (IN(10)) { phase_topk(p, G, wave, lane); } SEAM(10);
    if (IN(11)) {
        moe_tables(ctl + CW_CNT, lds, tid);
        const LAS int* pref = (const LAS int*)(lds + MOE_OFF);
        MoeUpOrder S{pref, pref + 260, (const int*)(ws + WS_ROWMAP), (const char*)(ws + WS_H2), (const char*)(ws + WS_WEU), G, (int)blockIdx.x};
        EpiUp E{pref, (bf16_t*)(ws + WS_HID)};
        pg8::gemm_phase<EpiUp, MoeUpOrder, true, true>(lds, 1024, 3072, 1024, S, E);
    } SEAM(11);
    if (IN(12)) {
        moe_tables(ctl + CW_CNT, lds, tid);
        const LAS int* pref = (const LAS int*)(lds + MOE_OFF);
        MoeDownOrder S{pref, (const char*)(ws + WS_HID), (const char*)(ws + WS_WED), G, (int)blockIdx.x};
        EpiDown E{pref + 260, (const int*)(ws + WS_ROWMAP), (const float*)(ws + WS_ROWW), (bf16_t*)(ws + WS_YS)};
        pg8::gemm_phase<EpiDown, MoeDownOrder, true, false>(lds, 256, 256, 256, S, E);
    } SEAM(12);
    if (IN(13)) { phase_combine(p, G, tid); }
#undef IN
#undef SEAM
}

extern "C" void kernel_launch(void* const* d_in, const int* in_sizes, int n_in, void* d_out, int out_size, void* d_ws, size_t ws_size, hipStream_t stream) {
    static int grid = 0;
    if (grid == 0) {
        if (n_in != 37 || in_sizes[0] != M * D || out_size != M * D || ws_size < WS_END) { fprintf(stderr, "kernel_launch: unexpected sizes (n_in %d, in0 %d, out %d, ws %zu, need %zu); nothing launched\n", n_in, n_in > 0 ? in_sizes[0] : -1, out_size, ws_size, (size_t)WS_END); grid = -1; return; }
        int dev = 0, cus = 0, per_cu = 0;
        if (hipGetDevice(&dev) != hipSuccess || hipDeviceGetAttribute(&cus, hipDeviceAttributeMultiprocessorCount, dev) != hipSuccess) { grid = -1; return; }
        if (hipFuncSetAttribute((const void*)hybrid_fwd, hipFuncAttributeMaxDynamicSharedMemorySize, LDS_BYTES) != hipSuccess) { fprintf(stderr, "kernel_launch: hipFuncSetAttribute failed\n"); grid = -1; return; }
        if (hipOccupancyMaxActiveBlocksPerMultiprocessor(&per_cu, (const void*)hybrid_fwd, 512, LDS_BYTES) != hipSuccess || per_cu < 1) fprintf(stderr, "kernel_launch: occupancy query reports %d\n", per_cu);
        (void)hipGetLastError();
        grid = cus;
        if (grid != 256) fprintf(stderr, "kernel_launch: %d CUs (built for 256)\n", grid);
    }
    if (grid < 0) return;
    if (hipMemsetAsync((char*)d_ws + WS_CTL, 0, CTL_ZERO_BYTES, stream) != hipSuccess) return;
    Params a{};
    for (int i = 0; i < 37; ++i) a.in[i] = (const float*)d_in[i];
    a.out = (float*)d_out; a.ws = (unsigned char*)d_ws;
#if MK_ONE_LAUNCH
    a.ph_lo = 0; a.ph_hi = NPHASE;
    hipLaunchKernelGGL(hybrid_fwd, dim3(grid), dim3(512), LDS_BYTES, stream, a);
#else
    for (int ph = 0; ph < NPHASE; ++ph) { a.ph_lo = ph; a.ph_hi = ph + 1; hipLaunchKernelGGL(hybrid_fwd, dim3(grid), dim3(512), LDS_BYTES, stream, a); }
#endif
}
```

```cpp
#define MK_ONE_LAUNCH 1
#include <hip/hip_runtime.h>
#include <cstdio>
#include <cstdint>
#include <cmath>

#define LAS __attribute__((address_space(3)))
#define GAS __attribute__((address_space(1)))
typedef unsigned short bf16_t;
typedef short bf16x8 __attribute__((ext_vector_type(8)));
typedef short s16x4 __attribute__((ext_vector_type(4)));
typedef float f32x2 __attribute__((ext_vector_type(2)));
typedef float f32x4 __attribute__((ext_vector_type(4)));
typedef float f32x16 __attribute__((ext_vector_type(16)));
typedef unsigned u32x2 __attribute__((ext_vector_type(2)));
typedef unsigned u32x4 __attribute__((ext_vector_type(4)));

typedef __bf16 bf16x2_t __attribute__((ext_vector_type(2)));
__device__ __forceinline__ unsigned cvt_pk_bf16(float lo, float hi) { f32x2 v = {lo, hi}; bf16x2_t b = __builtin_convertvector(v, bf16x2_t); return __builtin_bit_cast(unsigned, b); }
__device__ __forceinline__ float bf2f(unsigned h) { return __uint_as_float(h << 16); }
__device__ __forceinline__ unsigned f2bf(float f) { unsigned u = __builtin_bit_cast(unsigned, f); return (u + 0x7fffu + ((u >> 16) & 1u)) >> 16; }
__device__ __forceinline__ unsigned pk2(float lo, float hi) { return f2bf(lo) | (f2bf(hi) << 16); }
__device__ __forceinline__ float sigmoidf_(float x) { return 1.f / (1.f + __expf(-x)); }
__device__ __forceinline__ float wave_sum(float v) {
#pragma unroll
    for (int o = 1; o < 64; o <<= 1) v += __shfl_xor(v, o);
    return v;
}

namespace pg8 {
constexpr int BM = 256, BK = 64, HALF = 128, HTB = HALF * BK * 2  , STAGE_BYTES = 8 * HTB, NXCD = 8, WGM = 8;

__host__ __device__ __forceinline__ int lds_byte(int r, int c) { const int st = (r >> 4) * 2 + (c >> 5), rr = r & 15, cc = c & 31, ob = rr * 64 + cc * 2; return st * 1024 + (ob ^ (((ob >> 9) & 1) << 5)); }
__host__ __device__ __forceinline__ void stage_rc(int b, int& R, int& C) { const int st = b / 1024, sb = b % 1024, swz = sb ^ (((sb >> 9) & 1) << 5); R = (st >> 1) * 16 + swz / 64; C = (st & 1) * 32 + (swz % 64) / 2; }
__host__ __device__ __forceinline__ int perm32(int rho) { const int n = rho >> 4, i = rho & 15; return 8 * (i >> 2) + 4 * n + (i & 3); }

struct Unit { int pm, pn, aux; const char* a; const char* b; };

__device__ __forceinline__ void tile_map(int wgid, int nM, int nN, int& pm, int& pn) {
    const int nwg = nM * nN;
    { const int q = nwg / NXCD, r = nwg % NXCD, xcd = wgid % NXCD, off = wgid / NXCD; wgid = (xcd < r ? xcd * (q + 1) : r * (q + 1) + (xcd - r) * q) + off; }
    const int nig = WGM * nN, gid = wgid / nig, fm = gid * WGM, gsz = (nM - fm) < WGM ? (nM - fm) : WGM;
    pm = fm + ((wgid % nig) % gsz); pn = (wgid % nig) / gsz;
}
struct PlainOrder {
    const char* A; const char* Bt; int nM, nN, nwg, G, c; size_t tA, tB;
    __device__ __forceinline__ void init(const void* A_, const void* Bt_, int M, int N, int lda, int ldb, int G_, int c_) {
        A = (const char*)A_; Bt = (const char*)Bt_; nM = M / BM; nN = N / BM; nwg = nM * nN; G = G_; c = c_; tA = (size_t)BM * lda * 2; tB = (size_t)BM * ldb * 2; }
    __device__ __forceinline__ bool next(int i, Unit& u) const {
        const long L = (long)i * G + c; if (L >= nwg) return false;
        tile_map((int)L, nM, nN, u.pm, u.pn); u.aux = 0; u.a = A + (size_t)u.pm * tA; u.b = Bt + (size_t)u.pn * tB; return true; }
    __device__ __forceinline__ int srcrow(const Unit&, int r) const { return r; }
};

template <class Epi, class Sched, bool ALIGN_EPI, bool GATHER>
__device__ __forceinline__ void gemm_phase(LAS unsigned char* lds, const int K, const int lda, const int ldb, const Sched& S, const Epi& E) {
    const int tid = threadIdx.x, wid = __builtin_amdgcn_readfirstlane(tid >> 6), lane = tid & 63, wr = wid >> 2, wc = wid & 3, fr = lane & 15, fq = lane >> 4;
    const int nt = K / BK;
    unsigned voffA[2][2], voffAn[2][2], voffB[2]; int Rr[2], Cc[2];
#pragma unroll
    for (int i = 0; i < 2; ++i) { int R, C; stage_rc(tid * 16 + i * 8192, R, C); const int Rb = Epi::PERM ? ((R & ~31) + perm32(R & 31)) : R;
        Rr[i] = R; Cc[i] = C; voffB[i] = (unsigned)(Rb * ldb + C) * 2u;
        voffA[0][i] = (unsigned)(R * lda + C) * 2u; voffA[1][i] = (unsigned)((R + HALF) * lda + C) * 2u; voffAn[0][i] = voffA[0][i]; voffAn[1][i] = voffA[1][i]; }
    const size_t kstep = (size_t)(BK * 2);
    const size_t hstepB = (size_t)HALF * ldb * 2;
    const unsigned ldsw = (unsigned)wid * 1024u;
    const int aoff = lds_byte(wr * 64 + fr, fq * 8), boff = lds_byte(wc * 32 + fr, fq * 8);
#define PG8_SA(b, h) (((b) * 2 + (h)) * HTB)
#define PG8_SB(b, h) ((4 + (b) * 2 + (h)) * HTB)
#define PG8_STAGE(bufoff, gbase, voff) do { _Pragma("unroll") for (int _i = 0; _i < 2; ++_i) \
        __builtin_amdgcn_global_load_lds((const unsigned*)((const char*)(gbase) + (voff)[_i]), (LAS unsigned*)(lds + (bufoff) + ldsw + _i * 8192), 16, 0, 0); } while (0)
#define PG8_LDA(dst, b, h) do { _Pragma("unroll") for (int m = 0; m < 4; ++m) _Pragma("unroll") for (int k = 0; k < 2; ++k) dst[m][k] = *(const LAS bf16x8*)(lds + PG8_SA(b, h) + aoff + m * 2048 + k * 1024); } while (0)
#define PG8_LDB(dst, b, h) do { _Pragma("unroll") for (int n = 0; n < 2; ++n) _Pragma("unroll") for (int k = 0; k < 2; ++k) dst[n][k] = *(const LAS bf16x8*)(lds + PG8_SB(b, h) + boff + n * 2048 + k * 1024); } while (0)
#define PG8_MMA(ai, bj, At, Bt) do { __builtin_amdgcn_s_setprio(1); _Pragma("unroll") for (int m = 0; m < 4; ++m) _Pragma("unroll") for (int n = 0; n < 2; ++n) _Pragma("unroll") for (int k = 0; k < 2; ++k) \
        acc[ai][bj][m][n] = __builtin_amdgcn_mfma_f32_16x16x32_bf16(Bt[n][k], At[m][k], acc[ai][bj][m][n], 0, 0, 0); __builtin_amdgcn_s_setprio(0); } while (0)
#define PG8_WAIT_V(n) asm volatile("s_waitcnt vmcnt(" #n ")" ::: "memory")
#define PG8_WAIT_L(n) asm volatile("s_waitcnt lgkmcnt(" #n ")" ::: "memory")
#define PG8_BAR __builtin_amdgcn_s_barrier()
#define PG8_SCHED __builtin_amdgcn_sched_barrier(0)
#define PG8_GATHER(dst, u) do { _Pragma("unroll") for (int _h = 0; _h < 2; ++_h) _Pragma("unroll") for (int _i = 0; _i < 2; ++_i) \
        dst[_h][_i] = (unsigned)(S.srcrow(u, _h * HALF + Rr[_i]) * lda + Cc[_i]) * 2u; } while (0)
    Unit cur, nxt; int ui = 0;
    if (!S.next(0, cur)) return;
    f32x4 acc[2][2][4][2];
#pragma unroll
    for (int a = 0; a < 2; ++a)
#pragma unroll
        for (int b = 0; b < 2; ++b)
#pragma unroll
            for (int m = 0; m < 4; ++m)
#pragma unroll
                for (int n = 0; n < 2; ++n) acc[a][b][m][n] = (f32x4){0.f, 0.f, 0.f, 0.f};
    bf16x8 At[4][2], B0[2][2], B1[2][2];
    const char* cA = cur.a; const char* cB = cur.b;
    if constexpr (GATHER) { PG8_GATHER(voffA, cur); }
    PG8_STAGE(PG8_SB(0, 0), cB, voffB); PG8_STAGE(PG8_SB(0, 1), cB + hstepB, voffB); PG8_STAGE(PG8_SA(0, 0), cA, voffA[0]); PG8_STAGE(PG8_SA(0, 1), cA, voffA[1]);
    if (wr == 1) PG8_BAR;
    PG8_WAIT_V(2); PG8_BAR;
    PG8_STAGE(PG8_SB(1, 0), cB + kstep, voffB); PG8_STAGE(PG8_SA(1, 0), cA + kstep, voffA[0]); PG8_STAGE(PG8_SB(1, 1), cB + hstepB + kstep, voffB);
    PG8_WAIT_V(6); PG8_BAR;
    for (;;) {
        const bool has_next = S.next(ui + 1, nxt);
        const char* nA = has_next ? nxt.a : cA; const char* nB = has_next ? nxt.b : cB;
        if constexpr (GATHER) { if (has_next) { PG8_GATHER(voffAn, nxt); } else {
#pragma unroll
            for (int h = 0; h < 2; ++h)
#pragma unroll
                for (int i = 0; i < 2; ++i) voffAn[h][i] = voffA[h][i]; } }
#pragma nounroll
        for (int t = 0; t < nt; t += 2) {
            const bool last = (t == nt - 2);
            const char* a1 = cA + (size_t)(t + 1) * kstep;
            const char* a2 = last ? nA : cA + (size_t)(t + 2) * kstep; const char* b2 = last ? nB : cB + (size_t)(t + 2) * kstep;
            const char* a3 = a2 + kstep; const char* b3 = b2 + kstep;
            unsigned va[2][2];
#pragma unroll
            for (int h = 0; h < 2; ++h)
#pragma unroll
                for (int i = 0; i < 2; ++i) va[h][i] = (GATHER && last) ? voffAn[h][i] : voffA[h][i];
            PG8_LDB(B0, 0, 0); PG8_LDB(B1, 0, 1); PG8_SCHED; PG8_LDA(At, 0, 0); PG8_STAGE(PG8_SA(1, 1), a1, voffA[1]);
            PG8_WAIT_V(8); PG8_WAIT_L(0); PG8_BAR; PG8_MMA(0, 0, At, B0); PG8_MMA(0, 1, At, B1); PG8_BAR; PG8_SCHED;
            PG8_LDA(At, 0, 1); PG8_STAGE(PG8_SB(0, 0), b2, voffB); PG8_STAGE(PG8_SB(0, 1), b2 + hstepB, voffB); PG8_STAGE(PG8_SA(0, 0), a2, va[0]);
            PG8_WAIT_V(8); PG8_WAIT_L(0); PG8_BAR; PG8_MMA(1, 0, At, B0); PG8_MMA(1, 1, At, B1); PG8_BAR; PG8_SCHED;
            PG8_LDB(B0, 1, 0); PG8_LDB(B1, 1, 1); PG8_SCHED; PG8_LDA(At, 1, 0); PG8_STAGE(PG8_SA(0, 1), a2, va[1]);
            PG8_WAIT_V(8); PG8_WAIT_L(0); PG8_BAR; PG8_MMA(0, 0, At, B0); PG8_MMA(0, 1, At, B1); PG8_BAR; PG8_SCHED;
            PG8_LDA(At, 1, 1); PG8_STAGE(PG8_SB(1, 0), b3, voffB); PG8_STAGE(PG8_SB(1, 1), b3 + hstepB, voffB); PG8_STAGE(PG8_SA(1, 0), a3, va[0]);
            PG8_WAIT_V(8); PG8_WAIT_L(0); PG8_BAR; PG8_MMA(1, 0, At, B0); PG8_MMA(1, 1, At, B1); PG8_BAR; PG8_SCHED;
        }
        if constexpr (ALIGN_EPI) { if (wr == 0) PG8_BAR; }
        E(acc, cur, wr, wc, fr, fq);
        if (!has_next) break;
#pragma unroll
        for (int a = 0; a < 2; ++a)
#pragma unroll
            for (int b = 0; b < 2; ++b)
#pragma unroll
                for (int m = 0; m < 4; ++m)
#pragma unroll
                    for (int n = 0; n < 2; ++n) acc[a][b][m][n] = (f32x4){0.f, 0.f, 0.f, 0.f};
        cur = nxt; cA = nA; cB = nB; ++ui;
        if constexpr (GATHER) {
#pragma unroll
            for (int h = 0; h < 2; ++h)
#pragma unroll
                for (int i = 0; i < 2; ++i) voffA[h][i] = voffAn[h][i]; }
        if constexpr (ALIGN_EPI) { if (wr == 1) PG8_BAR; }
    }
    PG8_WAIT_V(0);
    if constexpr (!ALIGN_EPI) { if (wr == 0) PG8_BAR; }
    PG8_BAR;
#undef PG8_SA
#undef PG8_SB
#undef PG8_STAGE
#undef PG8_LDA
#undef PG8_LDB
#undef PG8_MMA
#undef PG8_WAIT_V
#undef PG8_WAIT_L
#undef PG8_BAR
#undef PG8_SCHED
#undef PG8_GATHER
}
}
#define RLX_AGENT __ATOMIC_RELAXED, __HIP_MEMORY_SCOPE_AGENT
#define LDS_WAIT() asm volatile("s_waitcnt lgkmcnt(0)" ::: "memory")
#define VM_WAIT() asm volatile("s_waitcnt vmcnt(0)" ::: "memory")
__device__ __forceinline__ unsigned long long rt() { return __builtin_amdgcn_s_memrealtime(); }

#define XB_TMO      128
#define XB_XCNT(j)  (256  + 64 * (j))
#define XB_XSUB(j)  (1280 + 64 * (j))
#define XB_XGEN(j)  (2304 + 64 * (j))
#define XB_TOP      3328
#define XB_TOPGEN   3392
#define XCD_BAR_WORDS 3456
#define XB_SPIN_CAP (1u << 18)

__device__ __forceinline__ unsigned xb_ld(unsigned* p)              { return __hip_atomic_load(p, __ATOMIC_RELAXED, __HIP_MEMORY_SCOPE_AGENT); }
__device__ __forceinline__ unsigned xb_add(unsigned* p, unsigned v) { return __hip_atomic_fetch_add(p, v, __ATOMIC_RELAXED, __HIP_MEMORY_SCOPE_AGENT); }
__device__ __forceinline__ unsigned xb_xcc_id() { return (unsigned)__builtin_amdgcn_s_getreg((3 << 11) | 20) & 0xFu; }
#define XB_SPIN(cond, bar) do { unsigned _sp = 0; while (cond) { __builtin_amdgcn_s_sleep(1); \
    if ((++_sp & 255u) == 0u) { if (xb_ld(&(bar)[XB_TMO])) break; if (_sp > XB_SPIN_CAP) { atomicAdd(&(bar)[XB_TMO], 1u); break; } } } } while (0)

struct XcdBarrier {
    unsigned* bar; unsigned x;
    volatile LAS unsigned* st;
};

__device__ __forceinline__ XcdBarrier xcd_barrier_post(unsigned* bar, volatile LAS unsigned* st) {
    XcdBarrier b; b.bar = bar; b.x = xb_xcc_id(); b.st = st;
    if (threadIdx.x == 0) (void)xb_add(&bar[XB_XCNT(b.x)], 1u);
    return b;
}
__device__ __forceinline__ void xcd_barrier_complete(unsigned* bar, unsigned x, unsigned& nloc, unsigned& nx) {
    const unsigned G = gridDim.x * gridDim.y * gridDim.z;
    unsigned sum, cnt, mine, sp = 0u;
    for (;;) {
        sum = 0u; cnt = 0u; mine = 0u;
#pragma unroll
        for (unsigned j = 0; j < 16; ++j) { const unsigned c = xb_ld(&bar[XB_XCNT(j)]); sum += c; cnt += (c > 0u) ? 1u : 0u; mine = (j == x) ? c : mine; }
        if (sum == G) break;
        __builtin_amdgcn_s_sleep(1);
        if ((++sp & 255u) == 0u) { if (xb_ld(&bar[XB_TMO])) break; if (sp > XB_SPIN_CAP) { atomicAdd(&bar[XB_TMO], 1u); break; } }
    }
    nloc = mine > 0u ? mine : 1u; nx = cnt > 0u ? cnt : 1u;
}

__device__ __forceinline__ void xcd_barrier(const XcdBarrier& b) {
    asm volatile("s_waitcnt vmcnt(0)" ::: "memory");
    __syncthreads();
    if (threadIdx.x == 0) {
        unsigned* bar = b.bar;
        __builtin_amdgcn_s_waitcnt(0);
        unsigned nloc = b.st[0], nx = b.st[1];
        if (nloc == 0u) { xcd_barrier_complete(bar, b.x, nloc, nx); b.st[0] = nloc; b.st[1] = nx; }
        const unsigned old = xb_add(&bar[XB_XSUB(b.x)], 1u);
        const unsigned gen = old / nloc;
        if (old + 1u == (gen + 1u) * nloc) {
            __builtin_amdgcn_fence(__ATOMIC_RELEASE, "agent");
            asm volatile("s_waitcnt vmcnt(0)" ::: "memory");
            const unsigned og = xb_add(&bar[XB_TOP], 1u);
            const unsigned tg = og / nx;
            if (og + 1u == (tg + 1u) * nx) xb_add(&bar[XB_TOPGEN], 1u);
            else XB_SPIN(xb_ld(&bar[XB_TOPGEN]) == tg, bar);
            __builtin_amdgcn_fence(__ATOMIC_ACQUIRE, "agent");
            xb_add(&bar[XB_XGEN(b.x)], 1u);
            asm volatile("s_waitcnt vmcnt(0)" ::: "memory");
        } else {
            XB_SPIN(xb_ld(&bar[XB_XGEN(b.x)]) == gen, bar);
            __builtin_amdgcn_fence(__ATOMIC_ACQUIRE, "agent");
            asm volatile("s_waitcnt vmcnt(0)" ::: "memory");
        }
    }
    __syncthreads();
}

constexpr int NB = 4, SEQ = 4096, D = 1024, M = NB * SEQ;
constexpr int N1 = 5376;
constexpr int NE = 256, FE = 256, CAP = 16384;
constexpr float QSCALE = 0.125f * 1.4426950408889634f;
constexpr int NPHASE = 14;
#ifndef MK_ONE_LAUNCH
#define MK_ONE_LAUNCH 0
#endif

constexpr size_t MiB = 1u << 20;
constexpr size_t WS_CTL = 0, CTL_ZERO_BYTES = 1 * MiB;
constexpr size_t WS_MODP = 1 * MiB;
constexpr size_t WS_MODF = 1 * MiB + 800 * 1024;
constexpr size_t WS_SCAL = 1 * MiB + 960 * 1024;
constexpr size_t WS_COS = 2 * MiB, WS_SIN = 4 * MiB;
constexpr size_t WS_W1T = 6 * MiB;
constexpr size_t WS_WAT = 17 * MiB, WS_WBT = 18 * MiB;
constexpr size_t WS_WOT = 19 * MiB;
constexpr size_t WS_WRT = 21 * MiB;
constexpr size_t WS_XN = 24 * MiB;
constexpr size_t WS_QN = 56 * MiB, WS_KN = 72 * MiB, WS_VB = 88 * MiB;
constexpr size_t WS_PRW = 104 * MiB;
constexpr size_t WS_GATE = 160 * MiB;
constexpr size_t WS_ACAT = 224 * MiB;
constexpr size_t WS_MIXF = 256 * MiB;
constexpr size_t WS_MIX = 320 * MiB;
constexpr size_t WS_X1 = 352 * MiB;
constexpr size_t WS_H2 = 416 * MiB;
constexpr size_t WS_LOGIT = 512 * MiB;
constexpr size_t WS_ROWMAP = 528 * MiB, WS_ROWW = 544 * MiB;
constexpr size_t WS_RW = 560 * MiB, RW_STRIDE = 32 * MiB;
constexpr size_t WS_WEU = 816 * MiB;
constexpr size_t WS_WED = 1074 * MiB;
constexpr size_t WS_HID = 1203 * MiB;
constexpr size_t WS_YS = 1308 * MiB;
constexpr size_t WS_BON = 1596 * MiB;
#ifdef RK_PROBE
constexpr size_t WS_END = 1968 * MiB;
#else
constexpr size_t WS_END = 1597 * MiB;
#endif
#ifdef RK_PROBE
constexpr size_t WS_RWV1 = 1600 * MiB;
constexpr size_t WS_ACAT2 = 1856 * MiB;
constexpr size_t WS_DBG = 1872 * MiB;
constexpr int CW_PROBE = 9000;
#endif
constexpr int CW_BAR = 4096, CW_CNT = 8192, CW_ATTQ = 8704;

constexpr int RING_BYTES = 131072;
constexpr int LDSCTL_OFF = RING_BYTES, MISC_OFF = LDSCTL_OFF + 320, MOE_OFF = LDSCTL_OFF + 1024;
constexpr int LDS_BYTES = 147456;

struct Params { const float* in[37]; float* out; unsigned char* ws; int ph_lo, ph_hi; };

__device__ __forceinline__ void tr_item(const float* W, int N, int k0, int n0, bf16_t* WT, int ldt, int drow0, int dcol0, int mode, LAS float* scr, int lane) {
#pragma unroll 8
    for (int i = 0; i < 32; ++i) { const int kk = 2 * i + (lane >> 5); float v = W[(size_t)(k0 + kk) * N + n0 + (lane & 31)]; if (mode) v = v - bf2f(f2bf(v)); scr[kk * 33 + (lane & 31)] = v; }
    LDS_WAIT(); asm volatile("" ::: "memory");
    const int c = lane & 7;
#pragma unroll
    for (int j = 0; j < 4; ++j) { const int n = (lane >> 3) + 8 * j; const LAS float* s = scr + (8 * c) * 33 + n;
        u32x4 o; o.x = pk2(s[0 * 33], s[1 * 33]); o.y = pk2(s[2 * 33], s[3 * 33]); o.z = pk2(s[4 * 33], s[5 * 33]); o.w = pk2(s[6 * 33], s[7 * 33]);
        *(u32x4*)(WT + (size_t)(drow0 + n) * ldt + dcol0 + 8 * c) = o; }
    LDS_WAIT(); asm volatile("" ::: "memory");
}
__device__ __forceinline__ int qkmap(int n0) { const int qk = n0 >> 9, r = n0 & 511, hd = r >> 6, bj = (r & 63) >> 5; return (qk * 2 + (hd >> 2)) * 256 + bj * 128 + (hd & 3) * 32; }
__device__ __forceinline__ int ugmap(int n0) { return n0 < 256 ? ((n0 >> 7) * 256 + (n0 & 127)) : ((((n0 - 256) >> 7) * 256) + 128 + ((n0 - 256) & 127)); }

__device__ __forceinline__ void phase_prologue(const Params& p, LAS unsigned char* lds, int G, int wave, int lane) {
    unsigned char* ws = p.ws;
    LAS float* scr = (LAS float*)(lds + wave * 16384);
    const int gw = blockIdx.x * 8 + wave, NGW = G * 8;
    constexpr int I_IN = 16 * 104, I_GATE = 16 * 64, I_BA = 8 * 32, I_OUT = 16 * 32, I_R = 16 * 8, I_EU = 257 * 256, I_ED = 257 * 128;
    constexpr int NITEMS = I_IN + I_GATE + 2 * I_BA + I_OUT + I_R + I_EU + I_ED;
    for (int it = gw; it < NITEMS; it += NGW) {
        int r = it;
        if (r < I_IN) { const int kb = r / 104, n0 = (r % 104) * 32; tr_item(p.in[6], 3328, kb * 64, n0, (bf16_t*)(ws + WS_W1T), 1024, n0 < 1024 ? qkmap(n0) : n0, kb * 64, 0, scr, lane); continue; } r -= I_IN;
        if (r < I_GATE) { const int kb = r / 64, n0 = (r % 64) * 32; tr_item(p.in[7], 2048, kb * 64, n0, (bf16_t*)(ws + WS_W1T), 1024, 3328 + n0, kb * 64, 0, scr, lane); continue; } r -= I_GATE;
        if (r < I_BA) { const int kb = r / 32, n0 = (r % 32) * 32; tr_item(p.in[27], 1024, kb * 64, n0, (bf16_t*)(ws + WS_WAT), 512, n0, kb * 64, 0, scr, lane); continue; } r -= I_BA;
        if (r < I_BA) { const int kb = r / 32, n0 = (r % 32) * 32; tr_item(p.in[28], 1024, kb * 64, n0, (bf16_t*)(ws + WS_WBT), 512, n0, kb * 64, 0, scr, lane); continue; } r -= I_BA;
        if (r < I_OUT) { const int kb = r / 32, n0 = (r % 32) * 32; tr_item(p.in[29], 1024, kb * 64, n0, (bf16_t*)(ws + WS_WOT), 1024, n0, kb * 64, 0, scr, lane); continue; } r -= I_OUT;
        if (r < I_R) { const int kb = r / 8, n0 = (r % 8) * 32;
            tr_item(p.in[31], 256, kb * 64, n0, (bf16_t*)(ws + WS_WRT), 3072, n0, kb * 64, 0, scr, lane);
            tr_item(p.in[31], 256, kb * 64, n0, (bf16_t*)(ws + WS_WRT), 3072, n0, 1024 + kb * 64, 0, scr, lane);
            tr_item(p.in[31], 256, kb * 64, n0, (bf16_t*)(ws + WS_WRT), 3072, n0, 2048 + kb * 64, 1, scr, lane); continue; } r -= I_R;
        if (r < I_EU) { const int e = r >> 8, rr = r & 255, kb = rr >> 4, n0 = (rr & 15) * 32;
            const float* W = e < 256 ? p.in[33] + (size_t)e * 1024 * 512 : p.in[35];
            tr_item(W, 512, kb * 64, n0, (bf16_t*)(ws + WS_WEU) + (size_t)e * 512 * 1024, 1024, ugmap(n0), kb * 64, 0, scr, lane); continue; } r -= I_EU;
        { const int e = r >> 7, rr = r & 127, kb = rr >> 5, n0 = (rr & 31) * 32;
            const float* W = e < 256 ? p.in[34] + (size_t)e * 256 * 1024 : p.in[36];
            tr_item(W, 1024, kb * 64, n0, (bf16_t*)(ws + WS_WED) + (size_t)e * 1024 * 256, 256, n0, kb * 64, 0, scr, lane); }
    }
    { const float* c = p.in[1]; const float* wa = p.in[3]; float* MODP = (float*)(ws + WS_MODP);
      for (int item = gw; item < 768; item += NGW) { const int ks = item / 96, n0 = (item % 96) * 64, k0 = ks * 128;
        float s0[4], s1[4], acc[4];
#pragma unroll
        for (int b = 0; b < 4; ++b) { const float a = c[b * 1024 + k0 + lane], a2 = c[b * 1024 + k0 + 64 + lane]; s0[b] = a * sigmoidf_(a); s1[b] = a2 * sigmoidf_(a2); acc[b] = 0.f; }
#pragma unroll 8
        for (int kk = 0; kk < 64; ++kk) { const float w = wa[(size_t)(k0 + kk) * 6144 + n0 + lane];
#pragma unroll
            for (int b = 0; b < 4; ++b) acc[b] += __shfl(s0[b], kk) * w; }
#pragma unroll 8
        for (int kk = 0; kk < 64; ++kk) { const float w = wa[(size_t)(k0 + 64 + kk) * 6144 + n0 + lane];
#pragma unroll
            for (int b = 0; b < 4; ++b) acc[b] += __shfl(s1[b], kk) * w; }
#pragma unroll
        for (int b = 0; b < 4; ++b) MODP[(ks * 4 + b) * 6144 + n0 + lane] = acc[b]; } }
    { const int* pos = (const int*)p.in[2]; float* ct = (float*)(ws + WS_COS); float* st = (float*)(ws + WS_SIN);
      const double INVF[32] = {1, 0.74989420933245587, 0.56234132519034907, 0.42169650342858228, 0.31622776601683794, 0.23713737056616555, 0.17782794100389226, 0.1333521432163324,
          0.10000000000000001, 0.074989420933245579, 0.056234132519034905, 0.042169650342858224, 0.031622776601683791, 0.02371373705661655, 0.017782794100389229, 0.013335214321633241,
          0.01, 0.0074989420933245588, 0.005623413251903491, 0.0042169650342858229, 0.003162277660168379, 0.0023713737056616549, 0.001778279410038923, 0.0013335214321633241,
          0.001, 0.00074989420933245575, 0.0005623413251903491, 0.00042169650342858229, 0.00031622776601683794, 0.00023713737056616554, 0.00017782794100389227, 0.0001333521432163324};
      for (int idx = gw * 64 + lane; idx < M * 32; idx += NGW * 64) { const int row = idx >> 5, i = idx & 31;
        double inv = 1.0;
#pragma unroll
        for (int j = 0; j < 32; ++j) inv = (i == j) ? INVF[j] : inv;
        const double rev = (double)pos[row] * inv * 0.15915494309189535; double fr = rev - floor(rev); if (fr > 0.5) fr -= 1.0;
        const float a = (float)(fr * 6.283185307179586);
        ct[idx] = __cosf(a); st[idx] = __sinf(a); } }
    if (gw == 0) { const float s1 = wave_sum(p.in[11][lane] * p.in[12][lane]), s2 = wave_sum(p.in[13][lane] * p.in[14][lane]);
        if (lane == 0) ((float*)(ws + WS_SCAL))[0] = expf(s1) - expf(s2) + 0.2f; }
}

__device__ __forceinline__ void norm_row(const float* xrow, const LAS float* mul, const LAS float* add, int lane, f32x4 (&y)[4]) {
    const f32x4* xr = (const f32x4*)xrow + lane; float s = 0.f;
#pragma unroll
    for (int j = 0; j < 4; ++j) { y[j] = xr[64 * j]; s += (y[j].x * y[j].x + y[j].y * y[j].y) + (y[j].z * y[j].z + y[j].w * y[j].w); }
    const float rstd = 1.f / sqrtf(wave_sum(s) * (1.f / D) + 1e-6f);
#pragma unroll
    for (int j = 0; j < 4; ++j) { const f32x4 mu = *(const LAS f32x4*)(mul + 4 * lane + 256 * j), ad = *(const LAS f32x4*)(add + 4 * lane + 256 * j); y[j] = y[j] * rstd * mu + ad; }
}
__device__ __forceinline__ void phase_norm1(const Params& p, LAS unsigned char* lds, int G, int tid, int wave, int lane) {
    unsigned char* ws = p.ws; const float* MODP = (const float*)(ws + WS_MODP); const float* bada = p.in[4]; float* MODF = (float*)(ws + WS_MODF);
    LAS float* mul = (LAS float*)lds; LAS float* add = mul + 1024;
    const int rows_per = M / G, r0 = blockIdx.x * rows_per, b = r0 / SEQ;
    for (int j = tid; j < 1024; j += 512) { float sh = bada[j], sc = bada[1024 + j];
#pragma unroll
        for (int ks = 0; ks < 8; ++ks) { sh += MODP[(ks * 4 + b) * 6144 + j]; sc += MODP[(ks * 4 + b) * 6144 + 1024 + j]; }
        mul[j] = p.in[5][j] * (1.f + sc); add[j] = sh; }
    for (int idx = blockIdx.x * 512 + tid; idx < 4 * 6144; idx += G * 512) { const int bb = idx / 6144, j = idx % 6144; float s = bada[j];
#pragma unroll
        for (int ks = 0; ks < 8; ++ks) s += MODP[(ks * 4 + bb) * 6144 + j];
        MODF[idx] = s; }
    __syncthreads();
    bf16_t* XN = (bf16_t*)(ws + WS_XN);
    for (int rr = wave; rr < rows_per; rr += 8) { const int row = r0 + rr; f32x4 y[4]; norm_row(p.in[0] + (size_t)row * D, mul, add, lane, y);
        unsigned long long* o8 = (unsigned long long*)(XN + (size_t)row * D) + lane;
#pragma unroll
        for (int j = 0; j < 4; ++j) o8[64 * j] = (unsigned long long)pk2(y[j].x, y[j].y) | ((unsigned long long)pk2(y[j].z, y[j].w) << 32); }
}
__device__ __forceinline__ void phase_norm2(const Params& p, LAS unsigned char* lds, int G, int tid, int wave, int lane) {
    unsigned char* ws = p.ws; const float* MODF = (const float*)(ws + WS_MODF);
    LAS float* mul = (LAS float*)lds; LAS float* add = mul + 1024;
    const int rows_per = M / G, r0 = blockIdx.x * rows_per, b = r0 / SEQ;
    for (int j = tid; j < 1024; j += 512) { mul[j] = p.in[30][j] * (1.f + MODF[b * 6144 + 4096 + j]); add[j] = MODF[b * 6144 + 3072 + j]; }
    __syncthreads();
    bf16_t* H2 = (bf16_t*)(ws + WS_H2); const float* X1 = (const float*)(ws + WS_X1);
    for (int rr = wave; rr < rows_per; rr += 8) { const int row = r0 + rr; f32x4 y[4]; norm_row(X1 + (size_t)row * D, mul, add, lane, y);
        unsigned long long* o8 = (unsigned long long*)(H2 + (size_t)row * 3072) + lane;
#pragma unroll
        for (int j = 0; j < 4; ++j) { const unsigned h0 = pk2(y[j].x, y[j].y), h1 = pk2(y[j].z, y[j].w);
            const unsigned l0 = pk2(y[j].x - bf2f(h0 & 0xffffu), y[j].y - bf2f(h0 >> 16)), l1 = pk2(y[j].z - bf2f(h1 & 0xffffu), y[j].w - bf2f(h1 >> 16));
            const unsigned long long hv = (unsigned long long)h0 | ((unsigned long long)h1 << 32), lv = (unsigned long long)l0 | ((unsigned long long)l1 << 32);
            o8[64 * j] = hv; o8[256 + 64 * j] = lv; o8[512 + 64 * j] = hv; } }
}

using pg8::Unit; using pg8::BM; using pg8::HALF;
__device__ __forceinline__ u32x4 pack8(const f32x4& a, const f32x4& b) { u32x4 w; w.x = cvt_pk_bf16(a[0], a[1]); w.y = cvt_pk_bf16(a[2], a[3]); w.z = cvt_pk_bf16(b[0], b[1]); w.w = cvt_pk_bf16(b[2], b[3]); return w; }
__device__ __forceinline__ void unpack8(const u32x4& w, f32x4& a, f32x4& b) { a = (f32x4){bf2f(w.x & 0xffffu), bf2f(w.x >> 16), bf2f(w.y & 0xffffu), bf2f(w.y >> 16)}; b = (f32x4){bf2f(w.z & 0xffffu), bf2f(w.z >> 16), bf2f(w.w & 0xffffu), bf2f(w.w >> 16)}; }

struct EpiG1 {
    static constexpr bool PERM = true;
    unsigned char* ws; const float *qg, *kg, *cosT, *sinT, *bgate;
    __device__ __forceinline__ void operator()(const f32x4 (&acc)[2][2][4][2], const Unit& u, int wr, int wc, int fr, int fq) const {
        const int row0 = u.pm * BM + wr * 64 + fr;
        if (u.pn < 4) {
            const bool isq = u.pn < 2; const float* g = isq ? qg : kg; bf16_t* O = (bf16_t*)(ws + (isq ? WS_QN : WS_KN)); const float osc = isq ? QSCALE : 1.f;
            const int hd = (u.pn & 1) * 4 + wc;
            f32x4 gv[2][2];
#pragma unroll
            for (int bj = 0; bj < 2; ++bj)
#pragma unroll
                for (int n = 0; n < 2; ++n) gv[bj][n] = *(const f32x4*)(g + 32 * bj + 8 * fq + 4 * n);
#pragma unroll
            for (int ai = 0; ai < 2; ++ai)
#pragma unroll
                for (int m = 0; m < 4; ++m) { const int row = row0 + ai * HALF + m * 16; float ss = 0.f;
#pragma unroll
                    for (int bj = 0; bj < 2; ++bj)
#pragma unroll
                        for (int n = 0; n < 2; ++n) { const f32x4 x = acc[ai][bj][m][n]; ss += (x[0] * x[0] + x[1] * x[1]) + (x[2] * x[2] + x[3] * x[3]); }
                    ss += __shfl_xor(ss, 16); ss += __shfl_xor(ss, 32);
                    const float rs = osc / sqrtf(ss * (1.f / 64.f) + 1e-6f);
                    f32x4 o1[2], o2[2];
#pragma unroll
                    for (int n = 0; n < 2; ++n) { const f32x4 c4 = *(const f32x4*)(cosT + (size_t)row * 32 + 8 * fq + 4 * n), s4 = *(const f32x4*)(sinT + (size_t)row * 32 + 8 * fq + 4 * n);
                        const f32x4 x1 = acc[ai][0][m][n] * gv[0][n] * rs, x2 = acc[ai][1][m][n] * gv[1][n] * rs;
                        o1[n] = x1 * c4 - x2 * s4; o2[n] = x2 * c4 + x1 * s4; }
                    bf16_t* dst = O + (size_t)row * 512 + hd * 64 + 8 * fq;
                    *(u32x4*)dst = pack8(o1[0], o1[1]); *(u32x4*)(dst + 32) = pack8(o2[0], o2[1]); }
        } else {
            int colt = u.pn * BM; size_t boff; int ld; bool gate = false;
            if (u.pn < 6) { boff = WS_VB; ld = 512; colt -= 1024; } else if (u.pn < 13) { boff = WS_PRW; ld = 1792; colt -= 1536; } else { boff = WS_GATE; ld = 2048; colt -= 3328; gate = true; }
            bf16_t* base = (bf16_t*)(ws + boff);
            const int col0 = colt + wc * 32 + 8 * fq;
            f32x4 bv[2][2];
#pragma unroll
            for (int bj = 0; bj < 2; ++bj)
#pragma unroll
                for (int n = 0; n < 2; ++n) bv[bj][n] = gate ? *(const f32x4*)(bgate + col0 + bj * HALF + 4 * n) : (f32x4){0.f, 0.f, 0.f, 0.f};
#pragma unroll
            for (int ai = 0; ai < 2; ++ai)
#pragma unroll
                for (int m = 0; m < 4; ++m) { bf16_t* rowp = base + (size_t)(row0 + ai * HALF + m * 16) * ld + col0;
#pragma unroll
                    for (int bj = 0; bj < 2; ++bj) { f32x4 v0 = acc[ai][bj][m][0] + bv[bj][0], v1 = acc[ai][bj][m][1] + bv[bj][1];
                        if (gate) {
#pragma unroll
                            for (int i = 0; i < 4; ++i) { v0[i] = sigmoidf_(v0[i]); v1[i] = sigmoidf_(v1[i]); } }
                        *(u32x4*)(rowp + bj * HALF) = pack8(v0, v1); } }
        }
    }
};

struct BranchOrder {
    const char *A, *Wa, *Wb; int G, c;
    __device__ __forceinline__ bool next(int i, Unit& u) const { const int tile = (i >> 1) * G + c; if (tile >= 256) return false;
        pg8::tile_map(tile, 64, 4, u.pm, u.pn); u.aux = i & 1; u.a = A + (size_t)u.pm * BM * 1024 * 2 + (u.aux ? 1024 : 0); u.b = (u.aux ? Wb : Wa) + (size_t)u.pn * BM * 512 * 2; return true; }
    __device__ __forceinline__ int srcrow(const Unit&, int r) const { return r; }
};
struct EpiBranch {
    static constexpr bool PERM = true;
    const bf16_t* GATE; float* MIXF; bf16_t* MIX;
    __device__ __forceinline__ void operator()(const f32x4 (&acc)[2][2][4][2], const Unit& u, int wr, int wc, int fr, int fq) const {
        const int row0 = u.pm * BM + wr * 64 + fr, col0 = u.pn * BM + wc * 32 + 8 * fq;
#pragma unroll
        for (int ai = 0; ai < 2; ++ai)
#pragma unroll
            for (int m = 0; m < 4; ++m) { const size_t row = (size_t)(row0 + ai * HALF + m * 16);
#pragma unroll
                for (int bj = 0; bj < 2; ++bj) { const int col = col0 + bj * HALF;
                    f32x4 g0, g1; unpack8(*(const u32x4*)(GATE + row * 2048 + (u.aux ? 1024 : 0) + col), g0, g1);
                    float* mf = MIXF + row * 1024 + col;
                    if (u.aux == 0) { *(f32x4*)mf = g0 * acc[ai][bj][m][0]; *(f32x4*)(mf + 4) = g1 * acc[ai][bj][m][1]; }
                    else { const f32x4 t0 = *(const f32x4*)mf + g0 * acc[ai][bj][m][0], t1 = *(const f32x4*)(mf + 4) + g1 * acc[ai][bj][m][1]; *(u32x4*)(MIX + row * 1024 + col) = pack8(t0, t1); } } }
    }
};
struct EpiOut {
    static constexpr bool PERM = true;
    const float* X; const float* MODF; float* X1;
    __device__ __forceinline__ void operator()(const f32x4 (&acc)[2][2][4][2], const Unit& u, int wr, int wc, int fr, int fq) const {
        const int row0 = u.pm * BM + wr * 64 + fr, col0 = u.pn * BM + wc * 32 + 8 * fq, b = (u.pm * BM) / SEQ;
        f32x4 gt[2][2];
#pragma unroll
        for (int bj = 0; bj < 2; ++bj)
#pragma unroll
            for (int n = 0; n < 2; ++n) gt[bj][n] = *(const f32x4*)(MODF + b * 6144 + 2048 + col0 + bj * HALF + 4 * n);
#pragma unroll
        for (int ai = 0; ai < 2; ++ai)
#pragma unroll
            for (int m = 0; m < 4; ++m) { const size_t off = (size_t)(row0 + ai * HALF + m * 16) * D + col0;
#pragma unroll
                for (int bj = 0; bj < 2; ++bj)
#pragma unroll
                    for (int n = 0; n < 2; ++n) { const size_t o = off + bj * HALF + 4 * n; *(f32x4*)(X1 + o) = *(const f32x4*)(X + o) + gt[bj][n] * acc[ai][bj][m][n]; } }
    }
};
struct EpiF32 {
    static constexpr bool PERM = true;
    float* O; int ldc;
    __device__ __forceinline__ void operator()(const f32x4 (&acc)[2][2][4][2], const Unit& u, int wr, int wc, int fr, int fq) const {
        const int row0 = u.pm * BM + wr * 64 + fr, col0 = u.pn * BM + wc * 32 + 8 * fq;
#pragma unroll
        for (int ai = 0; ai < 2; ++ai)
#pragma unroll
            for (int m = 0; m < 4; ++m) { float* rowp = O + (size_t)(row0 + ai * HALF + m * 16) * ldc + col0;
#pragma unroll
                for (int bj = 0; bj < 2; ++bj)
#pragma unroll
                    for (int n = 0; n < 2; ++n) *(f32x4*)(rowp + bj * HALF + 4 * n) = acc[ai][bj][m][n]; }
    }
};

struct RouterOrder {
    const char *A, *W; int G, c;
    __device__ __forceinline__ bool next(int i, Unit& u) const { const int L = i * G + c; if (L >= 256) return false; u.pm = L >> 2; u.pn = 0; u.aux = L & 3;
        u.a = A + (size_t)u.pm * BM * 3072 * 2 + u.aux * 768 * 2; u.b = W + u.aux * 768 * 2; return true; }
    __device__ __forceinline__ int srcrow(const Unit&, int r) const { return r; }
};
struct EpiF32P {
    static constexpr bool PERM = true;
    float* O;
    __device__ __forceinline__ void operator()(const f32x4 (&acc)[2][2][4][2], const Unit& u, int wr, int wc, int fr, int fq) const {
        const int row0 = u.pm * BM + wr * 64 + fr, col0 = wc * 32 + 8 * fq; float* P = O + (size_t)u.aux * M * 256;
#pragma unroll
        for (int ai = 0; ai < 2; ++ai)
#pragma unroll
            for (int m = 0; m < 4; ++m) { float* rowp = P + (size_t)(row0 + ai * HALF + m * 16) * 256 + col0;
#pragma unroll
                for (int bj = 0; bj < 2; ++bj)
#pragma unroll
                    for (int n = 0; n < 2; ++n) *(f32x4*)(rowp + bj * HALF + 4 * n) = acc[ai][bj][m][n]; }
    }
};
__device__ __forceinline__ void moe_tables(const unsigned* CNT, LAS unsigned char* lds, int tid) {
    LAS int* pref = (LAS int*)(lds + MOE_OFF); LAS int* cntl = pref + 260;
    __syncthreads();
    if (tid < 257) cntl[tid] = tid < 256 ? (int)__hip_atomic_load((unsigned*)CNT + tid, RLX_AGENT) : M;
    __syncthreads();
    if (tid == 0) { int s = 0; for (int e = 0; e < 257; ++e) { pref[e] = s; s += (cntl[e] + 255) >> 8; } pref[257] = s; }
    __syncthreads();
}
__device__ __forceinline__ int moe_find(const LAS int* pref, int j) { int lo = 0, hi = 257; while (hi - lo > 1) { const int mid = (lo + hi) >> 1; if (pref[mid] <= j) lo = mid; else hi = mid; } return lo; }
struct MoeUpOrder {
    const LAS int* pref; const LAS int* cntl; const int* rowmap; const char* A; const char* W; int G, c;
    __device__ __forceinline__ bool next(int i, Unit& u) const { const int L = i * G + c; if (L >= pref[257] * 2) return false; const int j = L >> 1, e = moe_find(pref, j);
        u.pm = j - pref[e]; u.pn = L & 1; u.aux = e; u.a = A; u.b = W + (size_t)e * (512 * 1024 * 2) + (size_t)u.pn * (BM * 1024 * 2); return true; }
    __device__ __forceinline__ int srcrow(const Unit& u, int r) const { const int lr = u.pm * BM + r, e = u.aux; if (e == 256) return lr; const int n = cntl[e]; return rowmap[e * CAP + (lr < n ? lr : 0)] >> 4; }
};
struct EpiUp {
    static constexpr bool PERM = true;
    const LAS int* pref; bf16_t* HID;
    __device__ __forceinline__ void operator()(const f32x4 (&acc)[2][2][4][2], const Unit& u, int wr, int wc, int fr, int fq) const {
        const int hrow0 = (pref[u.aux] + u.pm) * BM + wr * 64 + fr, col0 = u.pn * HALF + wc * 32 + 8 * fq;
#pragma unroll
        for (int ai = 0; ai < 2; ++ai)
#pragma unroll
            for (int m = 0; m < 4; ++m) { f32x4 h[2];
#pragma unroll
                for (int n = 0; n < 2; ++n) { const f32x4 g = acc[ai][0][m][n], up = acc[ai][1][m][n];
#pragma unroll
                    for (int i = 0; i < 4; ++i) h[n][i] = g[i] * sigmoidf_(g[i]) * up[i]; }
                *(u32x4*)(HID + (size_t)(hrow0 + ai * HALF + m * 16) * FE + col0) = pack8(h[0], h[1]); }
    }
};
struct MoeDownOrder {
    const LAS int* pref; const char* A; const char* W; int G, c;
    __device__ __forceinline__ bool next(int i, Unit& u) const { const int L = i * G + c; if (L >= pref[257] * 4) return false; const int j = L >> 2, e = moe_find(pref, j);
        u.pm = j - pref[e]; u.pn = L & 3; u.aux = e; u.a = A + (size_t)j * (BM * FE * 2); u.b = W + (size_t)e * (1024 * 256 * 2) + (size_t)u.pn * (BM * FE * 2); return true; }
    __device__ __forceinline__ int srcrow(const Unit&, int r) const { return r; }
};
struct EpiDown {
    static constexpr bool PERM = true;
    const LAS int* cntl; const int* rowmap; const float* roww; bf16_t* YS;
    __device__ __forceinline__ void operator()(const f32x4 (&acc)[2][2][4][2], const Unit& u, int wr, int wc, int fr, int fq) const {
        const int e = u.aux, n = cntl[e], lr0 = u.pm * BM + wr * 64 + fr, col0 = u.pn * BM + wc * 32 + 8 * fq;
#pragma unroll
        for (int ai = 0; ai < 2; ++ai)
#pragma unroll
            for (int m = 0; m < 4; ++m) { const int lr = lr0 + ai * HALF + m * 16;
                if (lr < n) { int v; float w; if (e == 256) { v = lr * 16 + 8; w = 1.f; } else { v = rowmap[e * CAP + lr]; w = roww[e * CAP + lr]; }
                    bf16_t* dst = YS + ((size_t)(v >> 4) * 9 + (v & 15)) * 1024 + col0;
#pragma unroll
                    for (int bj = 0; bj < 2; ++bj) *(u32x4*)(dst + bj * HALF) = pack8(acc[ai][bj][m][0] * w, acc[ai][bj][m][1] * w); } }
    }
};

namespace att {
constexpr int LDS_K0 = 0, LDS_K1 = 8192, LDS_V = 16384, LDS_WS = 32768, LDS_X = 36864;
__device__ __forceinline__ int crow(int r, int hi) { return (r & 3) + 8 * (r >> 2) + 4 * hi; }
__device__ __forceinline__ void qkt(f32x16& p0, f32x16& p1, const LAS unsigned char* Kslot, const bf16x8* qr, int r32, int hi) {
    const LAS unsigned char* kb = Kslot + hi * 1024 + r32 * 16; const f32x16 z = {};
#pragma unroll
    for (int d0 = 0; d0 < 4; ++d0) { const bf16x8 b0 = *(const LAS bf16x8*)(kb + d0 * 2048), b1 = *(const LAS bf16x8*)(kb + d0 * 2048 + 512);
        if (d0 == 0) { p0 = __builtin_amdgcn_mfma_f32_32x32x16_bf16(b0, qr[0], z, 0, 0, 0); p1 = __builtin_amdgcn_mfma_f32_32x32x16_bf16(b1, qr[0], z, 0, 0, 0); }
        else { p0 = __builtin_amdgcn_mfma_f32_32x32x16_bf16(b0, qr[d0], p0, 0, 0, 0); p1 = __builtin_amdgcn_mfma_f32_32x32x16_bf16(b1, qr[d0], p1, 0, 0, 0); } }
}
__device__ __forceinline__ void pv4(f32x16* o, int vb, bf16x8 pa0, bf16x8 pa1, bf16x8 pa2, bf16x8 pa3) {
#pragma unroll
    for (int d0 = 0; d0 < 4; ++d0) { s16x4 lo[4], hi[4];
#pragma unroll
        for (int ks = 0; ks < 4; ++ks) {
            asm volatile("ds_read_b64_tr_b16 %0,%1 offset:%c2" : "=&v"(lo[ks]) : "v"(vb), "i"(d0 * 4096 + ks * 1024) : "memory");
            asm volatile("ds_read_b64_tr_b16 %0,%1 offset:%c2" : "=&v"(hi[ks]) : "v"(vb), "i"(d0 * 4096 + ks * 1024 + 512) : "memory"); }
        asm volatile("s_waitcnt lgkmcnt(0)" ::: "memory"); __builtin_amdgcn_sched_barrier(0);
#define PK(k) (bf16x8){lo[k][0], lo[k][1], lo[k][2], lo[k][3], hi[k][0], hi[k][1], hi[k][2], hi[k][3]}
        o[d0] = __builtin_amdgcn_mfma_f32_32x32x16_bf16(pa0, PK(0), o[d0], 0, 0, 0);
        o[d0] = __builtin_amdgcn_mfma_f32_32x32x16_bf16(pa1, PK(1), o[d0], 0, 0, 0);
        o[d0] = __builtin_amdgcn_mfma_f32_32x32x16_bf16(pa2, PK(2), o[d0], 0, 0, 0);
        o[d0] = __builtin_amdgcn_mfma_f32_32x32x16_bf16(pa3, PK(3), o[d0], 0, 0, 0);
#undef PK
    }
}
__device__ __forceinline__ void attn_unit(int b, int h, int qb, const bf16_t* Qn, const bf16_t* Kn, const bf16_t* Vb, bf16_t* ACAT, const float* subg, float lam, LAS unsigned char* lds) {
    const int tid = threadIdx.x, lane = tid & 63, r32 = lane & 31, hi = lane >> 5; const int wid = __builtin_amdgcn_readfirstlane(tid >> 6), st = wid >> 2, wq = wid & 3;
    const long rowbase = (long)b * SEQ; const int q0 = qb * 128;
    const bf16_t* Qw = Qn + (rowbase + q0 + 32 * wq) * 512 + (2 * h + st) * 64;
    bf16x8 qr[4];
#pragma unroll
    for (int d0 = 0; d0 < 4; ++d0) qr[d0] = *(const bf16x8*)(Qw + (long)r32 * 512 + d0 * 16 + hi * 8);
    const int ntw = (q0 + 32 * wq) / 64 + 1, NT = q0 / 64 + 2;
    float m_run = -1e30f, l_run = 0.f; f32x16 o[4];
#pragma unroll
    for (int d0 = 0; d0 < 4; ++d0) o[d0] = f32x16{};
    LAS float* wsf = (LAS float*)(lds + LDS_WS) + wid * 128;
    const LAS unsigned char* Ks = lds + (st ? LDS_K1 : LDS_K0);
    const int vb0 = (int)(unsigned)(uintptr_t)(lds + LDS_V) + ((lane >> 4) & 1) * 32 + (lane & 3) * 8 + (4 * hi + ((lane & 15) >> 2)) * 64;
    const int c8 = tid >> 6, kvl = tid & 63;
    const bf16_t* kr0 = Kn + (rowbase + kvl) * 512 + (2 * h) * 64 + c8 * 8;
    const bf16_t* vr0[2]; int vdst[2];
#pragma unroll
    for (int j = 0; j < 2; ++j) { const int pidx = tid + 512 * j, ch = pidx & 3, key = (pidx >> 2) & 15, kg = (pidx >> 6) & 3, dblk = pidx >> 8;
        vr0[j] = Vb + (rowbase + kg * 16 + key) * 512 + h * 128 + dblk * 32 + ch * 8; vdst[j] = LDS_V + pidx * 16; }
    u32x4 k0v = *(const u32x4*)kr0, k1v = *(const u32x4*)(kr0 + 64), vv0 = *(const u32x4*)vr0[0], vv1 = *(const u32x4*)vr0[1];
    for (int t = 0; t < NT; ++t) {
        __syncthreads();
        *(LAS u32x4*)(lds + LDS_K0 + c8 * 1024 + kvl * 16) = k0v; *(LAS u32x4*)(lds + LDS_K1 + c8 * 1024 + kvl * 16) = k1v;
        *(LAS u32x4*)(lds + vdst[0]) = vv0; *(LAS u32x4*)(lds + vdst[1]) = vv1;
        __syncthreads();
        if (t + 1 < NT) { const size_t o = (size_t)(t + 1) * 64 * 512;
            k0v = *(const u32x4*)(kr0 + o); k1v = *(const u32x4*)(kr0 + o + 64); vv0 = *(const u32x4*)(vr0[0] + o); vv1 = *(const u32x4*)(vr0[1] + o); }
        if (t < ntw) {
            f32x16 p0, p1; qkt(p0, p1, Ks, qr, r32, hi);
            float rm = p0[0];
#pragma unroll
            for (int r = 0; r < 16; ++r) { rm = fmaxf(rm, p0[r]); rm = fmaxf(rm, p1[r]); }
            rm = fmaxf(rm, __shfl_xor(rm, 32));
            const float mnew = fmaxf(m_run, rm), alpha = __builtin_amdgcn_exp2f(m_run - mnew); m_run = mnew;
            float s = 0.f;
#pragma unroll
            for (int r = 0; r < 16; ++r) { p0[r] = __builtin_amdgcn_exp2f(p0[r] - mnew); p1[r] = __builtin_amdgcn_exp2f(p1[r] - mnew); s += p0[r] + p1[r]; }
            s += __shfl_xor(s, 32); l_run = l_run * alpha + s;
            if (hi == 0) wsf[r32] = alpha;
            LDS_WAIT();
#pragma unroll
            for (int r = 0; r < 16; ++r) { const float f = wsf[crow(r, hi)];
#pragma unroll
                for (int d0 = 0; d0 < 4; ++d0) o[d0][r] *= f; }
            u32x4 pw0, pw1, pw2, pw3;
#define PKW(P, B) cvt_pk_bf16(P[B], P[B + 1])
            pw0 = (u32x4){PKW(p0, 0), PKW(p0, 2), PKW(p0, 4), PKW(p0, 6)}; pw1 = (u32x4){PKW(p0, 8), PKW(p0, 10), PKW(p0, 12), PKW(p0, 14)};
            pw2 = (u32x4){PKW(p1, 0), PKW(p1, 2), PKW(p1, 4), PKW(p1, 6)}; pw3 = (u32x4){PKW(p1, 8), PKW(p1, 10), PKW(p1, 12), PKW(p1, 14)};
#undef PKW
            pv4(o, vb0, __builtin_bit_cast(bf16x8, pw0), __builtin_bit_cast(bf16x8, pw1), __builtin_bit_cast(bf16x8, pw2), __builtin_bit_cast(bf16x8, pw3));
        }
    }
    if (hi == 0) wsf[32 + r32] = l_run;
    LDS_WAIT();
    float rli[16];
#pragma unroll
    for (int r = 0; r < 16; ++r) rli[r] = 1.f / wsf[32 + crow(r, hi)];
    LAS float* X = (LAS float*)(lds + LDS_X) + wq * (32 * 128);
    if (st == 1) {
#pragma unroll
        for (int d0 = 0; d0 < 4; ++d0)
#pragma unroll
            for (int r = 0; r < 16; ++r) X[crow(r, hi) * 128 + d0 * 32 + r32] = o[d0][r] * rli[r];
    }
    __syncthreads();
    if (st == 0) {
        float ss[16];
#pragma unroll
        for (int r = 0; r < 16; ++r) ss[r] = 0.f;
#pragma unroll
        for (int d0 = 0; d0 < 4; ++d0)
#pragma unroll
            for (int r = 0; r < 16; ++r) { const float v = o[d0][r] * rli[r] - lam * X[crow(r, hi) * 128 + d0 * 32 + r32]; o[d0][r] = v; ss[r] += v * v; }
#pragma unroll
        for (int r = 0; r < 16; ++r) {
#pragma unroll
            for (int off = 1; off < 32; off <<= 1) ss[r] += __shfl_xor(ss[r], off);
            ss[r] = 0.8f / sqrtf(ss[r] * (1.f / 128.f) + 1e-5f); }
#pragma unroll
        for (int d0 = 0; d0 < 4; ++d0) { const float g = subg[d0 * 32 + r32];
#pragma unroll
            for (int r = 0; r < 16; ++r) ACAT[(size_t)(rowbase + q0 + 32 * wq + crow(r, hi)) * 1024 + h * 128 + d0 * 32 + r32] = (bf16_t)f2bf(o[d0][r] * ss[r] * g); }
    }
}
}


namespace rk {
typedef bf16x8 frag;
constexpr size_t CELL = 131072;
constexpr int S_KKE = 0, S_RD = 8192, S_BI = 16384, S_KI = 24576, F_BIB = 32768, F_KIB = 40960, F_VB = 49152, F_ARBA = 57344, F_ARKA = 65536, O_P = 73728, O_QT = 81920, O_GA = 98304, O_Y0 = 106496, O_S0B = 122880;
__device__ __forceinline__ int crow(int r, int hi) { return (r & 3) + 8 * (r >> 2) + 4 * hi; }
__device__ __forceinline__ void swap32(unsigned& a, unsigned& b) { auto r = __builtin_amdgcn_permlane32_swap(a, b, false, false); a = r[0]; b = r[1]; }
__device__ __forceinline__ void swap32f(float& a, float& b) { unsigned ua = __float_as_uint(a), ub = __float_as_uint(b); swap32(ua, ub); a = __uint_as_float(ua); b = __uint_as_float(ub); }
__device__ __forceinline__ f32x16 mma(frag a, frag b, f32x16 c) { return __builtin_amdgcn_mfma_f32_32x32x16_bf16(a, b, c, 0, 0, 0); }
__device__ __forceinline__ frag mkfrag(unsigned a, unsigned b, unsigned c, unsigned d) { u32x4 w = {a, b, c, d}; return __builtin_bit_cast(frag, w); }
__device__ __forceinline__ frag pack_half(const f32x16& x, int half) { const int b = 8 * half; return mkfrag(cvt_pk_bf16(x[b], x[b + 1]), cvt_pk_bf16(x[b + 2], x[b + 3]), cvt_pk_bf16(x[b + 4], x[b + 5]), cvt_pk_bf16(x[b + 6], x[b + 7])); }
__device__ __forceinline__ void load_rm(const GAS bf16_t* S, int lane, frag (&f)[2][4]) {
#pragma unroll
    for (int t = 0; t < 2; ++t)
#pragma unroll
        for (int s = 0; s < 4; ++s) f[t][s] = *(const GAS frag*)(S + (32 * t + (lane & 31)) * 64 + 16 * s + 8 * (lane >> 5));
}
__device__ __forceinline__ void dump_frag(GAS unsigned char* F, int f, int lane, frag v) { *(GAS frag*)(F + f * 1024 + lane * 16) = v; }
__device__ __forceinline__ frag load_frag(const GAS unsigned char* F, int f, int lane) { return *(const GAS frag*)(F + f * 1024 + lane * 16); }
__device__ __forceinline__ void dump_tile_f32(GAS unsigned char* F, int tile, int lane, const f32x16& x) {
#pragma unroll
    for (int q = 0; q < 4; ++q) *(GAS f32x4*)(F + (tile * 4 + q) * 1024 + lane * 16) = (f32x4){x[4 * q], x[4 * q + 1], x[4 * q + 2], x[4 * q + 3]};
}
__device__ __forceinline__ f32x16 load_tile_f32(const GAS unsigned char* F, int tile, int lane) { f32x16 x;
#pragma unroll
    for (int q = 0; q < 4; ++q) { const f32x4 v = *(const GAS f32x4*)(F + (tile * 4 + q) * 1024 + lane * 16); x[4 * q] = v[0]; x[4 * q + 1] = v[1]; x[4 * q + 2] = v[2]; x[4 * q + 3] = v[3]; }
    return x; }
__device__ __forceinline__ void cm_to_lc(f32x16 (&C)[2][2], float (&lc)[64]) {
    asm volatile("s_nop 15\n\ts_nop 15" : "+v"(C[0][0]), "+v"(C[0][1]), "+v"(C[1][0]), "+v"(C[1][1]));
#pragma unroll
    for (int tm = 0; tm < 2; ++tm)
#pragma unroll
        for (int r = 0; r < 16; ++r) { float a = C[tm][0][r], b = C[tm][1][r]; swap32f(a, b); lc[32 * tm + crow(r, 0)] = a; lc[32 * tm + crow(r, 1)] = b; }
}
__device__ __forceinline__ void lc16_to_frags(const float (&v)[16], frag& f0, frag& f1) {
    unsigned X[4], Y[4];
#pragma unroll
    for (int i = 0; i < 4; ++i) { const int j0 = 2 * i, j1 = 2 * i + 1; const int t0 = (j0 & 3) + 8 * (j0 >> 2), t1 = (j1 & 3) + 8 * (j1 >> 2);
        X[i] = cvt_pk_bf16(v[t0], v[t1]); Y[i] = cvt_pk_bf16(v[t0 + 4], v[t1 + 4]); swap32(X[i], Y[i]); }
    f0 = mkfrag(X[0], X[1], X[2], X[3]); f1 = mkfrag(Y[0], Y[1], Y[2], Y[3]);
}
__device__ __forceinline__ void lc_to_frags(const float (&lc)[64], frag (&out)[4][2]) {
#pragma unroll
    for (int s = 0; s < 4; ++s) { float v[16];
#pragma unroll
        for (int i = 0; i < 16; ++i) v[i] = lc[16 * s + i];
        lc16_to_frags(v, out[s][0], out[s][1]); }
}
__device__ __forceinline__ void shift8(const bf16_t* PRW, int row, bool hasprev, int col, const float* mu, float (&x)[8]) {
    f32x4 c0, c1, p0, p1; unpack8(*(const u32x4*)(PRW + (size_t)row * 1792 + col), c0, c1);
    if (hasprev) unpack8(*(const u32x4*)(PRW + (size_t)(row - 1) * 1792 + col), p0, p1); else { p0 = (f32x4){0.f, 0.f, 0.f, 0.f}; p1 = p0; }
    const f32x4 m0 = *(const f32x4*)(mu + col), m1 = *(const f32x4*)(mu + col + 4);
    const f32x4 y0 = c0 + (p0 - c0) * m0, y1 = c1 + (p1 - c1) * m1;
#pragma unroll
    for (int i = 0; i < 4; ++i) { x[i] = y0[i]; x[4 + i] = y1[i]; }
}
__device__ __forceinline__ float fsigm(float x) { return __builtin_amdgcn_rcpf(1.f + __expf(-x)); }
__device__ __forceinline__ float ftanh(float x) { return 1.f - 2.f * __builtin_amdgcn_rcpf(1.f + __expf(2.f * x)); }
__device__ __forceinline__ float rdlane(float v, int l) { return __uint_as_float((unsigned)__builtin_amdgcn_readlane((int)__float_as_uint(v), l)); }
__device__ __forceinline__ float reduce16(const float (&v)[16], int lane) {
    float w[8], u[4], y[2];
#pragma unroll
    for (int j = 0; j < 8; ++j) { float a = v[j], b = v[j + 8]; swap32f(a, b); w[j] = a + b; }
#pragma unroll
    for (int j = 0; j < 4; ++j) { auto r = __builtin_amdgcn_permlane16_swap(__float_as_uint(w[j]), __float_as_uint(w[j + 4]), false, false); u[j] = __uint_as_float(r[0]) + __uint_as_float(r[1]); }
    const bool b3 = (lane & 8) != 0, b2 = (lane & 4) != 0;
#pragma unroll
    for (int j = 0; j < 2; ++j) { const float keep = b3 ? u[j + 2] : u[j], send = b3 ? u[j] : u[j + 2]; y[j] = keep + __shfl_xor(send, 8); }
    const float keep = b2 ? y[1] : y[0], send = b2 ? y[0] : y[1]; float z = keep + __shfl_xor(send, 4);
    z += __shfl_xor(z, 2); z += __shfl_xor(z, 1); return z;
}
__device__ __forceinline__ constexpr int red16_lane(int tt) { return 32 * ((tt >> 3) & 1) + 16 * ((tt >> 2) & 1) + 8 * ((tt >> 1) & 1) + 4 * (tt & 1); }
template <class T> __device__ __forceinline__ T* launder(T* q) { asm volatile("" : "+s"(q)); return q; }
__device__ __forceinline__ frag colfrag(const float* W, int ldw, int k0, int col) {
    float v[8];
#pragma unroll
    for (int j = 0; j < 8; ++j) v[j] = W[(size_t)(k0 + j) * ldw + col];
    return mkfrag(cvt_pk_bf16(v[0], v[1]), cvt_pk_bf16(v[2], v[3]), cvt_pk_bf16(v[4], v[5]), cvt_pk_bf16(v[6], v[7]));
}

__device__ __forceinline__ void r1_cell(const Params& p, int chunk, int h, LAS unsigned char* lds, int lane) {
    asm volatile("" : "+v"(lane));
    unsigned char* ws = launder(p.ws); const bf16_t* PRW = (const bf16_t*)(ws + WS_PRW); const float* mu = launder(p.in[16]);
    const float* wd2 = launder(p.in[18]); const float* a2w = launder(p.in[20]);
    int l31 = lane & 31, hi = lane >> 5; const int row0 = chunk * 64, c = h * 64 + lane; const bool first = (row0 % SEQ) == 0;
    const int cell = chunk * 8 + h;
    GAS unsigned char* cs = (GAS unsigned char*)(ws + WS_RW + (size_t)cell * CELL);
#define RK_FENCE() do { asm volatile("" ::: "memory"); __builtin_amdgcn_sched_barrier(0); } while (0)
    const f32x16 Z = {};
    float wl[64], al[64];
    { f32x16 CW[2][2], CA[2][2];
#pragma unroll
      for (int i = 0; i < 2; ++i)
#pragma unroll
          for (int j = 0; j < 2; ++j) { CW[i][j] = Z; CA[i][j] = Z; }
#pragma unroll
      for (int s = 0; s < 4; ++s) { frag Aw[2], Aa[2];
#pragma unroll
          for (int tm = 0; tm < 2; ++tm) { const int tl = 32 * tm + l31, row = row0 + tl; const bool hp = !(first && tl == 0); float x[8];
              shift8(PRW, row, hp, 1536 + 16 * s + 8 * hi, mu, x);
              Aw[tm] = mkfrag(cvt_pk_bf16(ftanh(x[0]), ftanh(x[1])), cvt_pk_bf16(ftanh(x[2]), ftanh(x[3])), cvt_pk_bf16(ftanh(x[4]), ftanh(x[5])), cvt_pk_bf16(ftanh(x[6]), ftanh(x[7])));
              shift8(PRW, row, hp, 1600 + 16 * s + 8 * hi, mu, x);
              Aa[tm] = mkfrag(cvt_pk_bf16(x[0], x[1]), cvt_pk_bf16(x[2], x[3]), cvt_pk_bf16(x[4], x[5]), cvt_pk_bf16(x[6], x[7])); }
#pragma unroll
          for (int tn = 0; tn < 2; ++tn) { const frag Bw = colfrag(wd2, 512, 16 * s + 8 * hi, h * 64 + 32 * tn + l31), Ba = colfrag(a2w, 512, 16 * s + 8 * hi, h * 64 + 32 * tn + l31);
#pragma unroll
              for (int tm = 0; tm < 2; ++tm) { CW[tm][tn] = mma(Aw[tm], Bw, CW[tm][tn]); CA[tm][tn] = mma(Aa[tm], Ba, CA[tm][tn]); } } }
      cm_to_lc(CW, wl); cm_to_lc(CA, al); }
    { const float w0 = p.in[17][c]; float cl = 0.f;
#pragma unroll
      for (int t = 0; t < 64; ++t) { const float u = -(w0 + wl[t]); const float sp = u > 20.f ? u : __logf(1.f + __expf(u)); cl -= __expf(-sp - 0.5f); wl[t] = cl; } }
    const float DL = __expf(wl[63]);
    { const float a0c = p.in[19][c], kkc = p.in[22][c], kac = p.in[23][c], rkc = p.in[24][c], mur = mu[c], muk = mu[512 + c], muv = mu[1024 + c];
      float pr = 0.f, pk = 0.f, pvv = 0.f, bon = 0.f;
      if (!first) { const bf16_t* q = PRW + (size_t)(row0 - 1) * 1792 + c; pr = bf2f(q[0]); pk = bf2f(q[512]); pvv = bf2f(q[1024]); }
      GAS bf16_t* SKKe = (GAS bf16_t*)(cs + S_KKE); GAS bf16_t* SRd = (GAS bf16_t*)(cs + S_RD); GAS bf16_t* SBi = (GAS bf16_t*)(cs + S_BI); GAS bf16_t* SKi = (GAS bf16_t*)(cs + S_KI);
#pragma unroll
      for (int s = 0; s < 4; ++s) { float bi16[16], ki16[16], v16[16], q1[16], q2[16];
          { float pr1 = pr, pk1 = pk;
#pragma unroll
            for (int tt = 0; tt < 16; ++tt) { const int t = 16 * s + tt; const GAS bf16_t* q = (const GAS bf16_t*)PRW + (size_t)(row0 + t) * 1792 + c;
                const float cr = bf2f(q[0]), ck = bf2f(q[512]);
                const float xr = cr + (pr1 - cr) * mur, xk = ck + (pk1 - ck) * muk; pr1 = cr; pk1 = ck;
                const float a = fsigm(a0c + al[t]); const float kmod = xk * (1.f + (a - 1.f) * kac), kkv = xk * kkc;
                q1[tt] = kkv * kkv; q2[tt] = xr * kmod * rkc; if ((tt & 3) == 3) RK_FENCE(); } }
          const float z1 = reduce16(q1, lane), z2 = reduce16(q2, lane);
          RK_FENCE();
#pragma unroll
          for (int tt = 0; tt < 16; ++tt) { const int t = 16 * s + tt; const GAS bf16_t* q = (const GAS bf16_t*)PRW + (size_t)(row0 + t) * 1792 + c;
              const float cr = bf2f(q[0]), ck = bf2f(q[512]), cv = bf2f(q[1024]);
              const float xr = cr + (pr - cr) * mur, xk = ck + (pk - ck) * muk, xv = cv + (pvv - cv) * muv; pr = cr; pk = ck; pvv = cv;
              const float a = fsigm(a0c + al[t]);
              const float Dt = __expf(wl[t]), Et = t == 0 ? 1.f : __expf(wl[t > 0 ? t - 1 : 0]), iD = __expf(-wl[t]);
              const float ss = rdlane(z1, red16_lane(tt)), bs = rdlane(z2, red16_lane(tt)); if (lane == t) bon = bs;
              const float kkn = xk * kkc * __builtin_amdgcn_rsqf(fmaxf(ss, 1e-24f));
              const float kmod = xk * (1.f + (a - 1.f) * kac), bb = kkn * a;
              const float kket = kkn * Et, rd = xr * Dt, bi = bb * iD, ki = kmod * iD;
              const unsigned p0 = cvt_pk_bf16(kket, rd), p1 = cvt_pk_bf16(bi, ki);
              SKKe[t * 64 + lane] = (bf16_t)(p0 & 0xffffu); SRd[t * 64 + lane] = (bf16_t)(p0 >> 16); SBi[t * 64 + lane] = (bf16_t)(p1 & 0xffffu); SKi[t * 64 + lane] = (bf16_t)(p1 >> 16);
              bi16[tt] = bi; ki16[tt] = ki; v16[tt] = xv; if ((tt & 3) == 3) RK_FENCE(); }
          frag f0, f1;
          lc16_to_frags(bi16, f0, f1); dump_frag(cs + F_BIB, 2 * s, lane, f0); dump_frag(cs + F_BIB, 2 * s + 1, lane, f1);
          lc16_to_frags(ki16, f0, f1); dump_frag(cs + F_KIB, 2 * s, lane, f0); dump_frag(cs + F_KIB, 2 * s + 1, lane, f1);
          lc16_to_frags(v16, f0, f1); dump_frag(cs + F_VB, 2 * s, lane, f0); dump_frag(cs + F_VB, 2 * s + 1, lane, f1); }
      ((GAS float*)(ws + WS_BON))[cell * 64 + lane] = bon; }
    asm volatile("s_waitcnt vmcnt(0) lgkmcnt(0)" ::: "memory");
    float x2[64];
    { frag KiF[2][4], KKeF[2][4];
      { frag BiF[2][4];
        load_rm((const GAS bf16_t*)(cs + S_KKE), lane, KKeF); load_rm((const GAS bf16_t*)(cs + S_BI), lane, BiF);
        frag RdF[2][4]; load_rm((const GAS bf16_t*)(cs + S_RD), lane, RdF);
#pragma unroll
        for (int tmi = 0; tmi < 2; ++tmi)
#pragma unroll
            for (int tnt = tmi; tnt < 2; ++tnt) { f32x16 a = Z;
#pragma unroll
                for (int s = 0; s < 4; ++s) a = mma(BiF[tmi][s], RdF[tnt][s], a);
                if (tmi == tnt) {
#pragma unroll
                    for (int r = 0; r < 16; ++r) a[r] = crow(r, hi) <= l31 ? a[r] : 0.f; }
                dump_frag(cs + F_ARBA, (2 * tmi) * 2 + tnt, lane, pack_half(a, 0)); dump_frag(cs + F_ARBA, (2 * tmi + 1) * 2 + tnt, lane, pack_half(a, 1)); }
        RK_FENCE();
        load_rm((const GAS bf16_t*)(cs + S_KI), lane, KiF);
#pragma unroll
        for (int tmi = 0; tmi < 2; ++tmi)
#pragma unroll
            for (int tnt = tmi; tnt < 2; ++tnt) { f32x16 a = Z;
#pragma unroll
                for (int s = 0; s < 4; ++s) a = mma(KiF[tmi][s], RdF[tnt][s], a);
                if (tmi == tnt) {
#pragma unroll
                    for (int r = 0; r < 16; ++r) a[r] = crow(r, hi) <= l31 ? a[r] : 0.f; }
                dump_frag(cs + F_ARKA, (2 * tmi) * 2 + tnt, lane, pack_half(a, 0)); dump_frag(cs + F_ARKA, (2 * tmi + 1) * 2 + tnt, lane, pack_half(a, 1)); }
        RK_FENCE(); }
      frag NmA[2][4];
#pragma unroll
      for (int tmi = 0; tmi < 2; ++tmi)
#pragma unroll
          for (int tnt = tmi; tnt < 2; ++tnt) { f32x16 a = Z;
#pragma unroll
              for (int s = 0; s < 4; ++s) a = mma(KiF[tmi][s], KKeF[tnt][s], a);
              if (tmi == tnt) {
#pragma unroll
                  for (int r = 0; r < 16; ++r) a[r] = crow(r, hi) < l31 ? a[r] : 0.f; }
              NmA[tnt][2 * tmi] = pack_half(a, 0); NmA[tnt][2 * tmi + 1] = pack_half(a, 1); }
      RK_FENCE();
      { f32x16 NV[2][2];
#pragma unroll
        for (int tn = 0; tn < 2; ++tn) { NV[0][tn] = Z; NV[1][tn] = Z;
#pragma unroll
            for (int ks = 0; ks < 4; ++ks) { const frag vb = load_frag(cs + F_VB, 2 * ks + tn, lane);
                if (ks < 2) NV[0][tn] = mma(NmA[0][ks], vb, NV[0][tn]);
                NV[1][tn] = mma(NmA[1][ks], vb, NV[1][tn]); } }
        cm_to_lc(NV, x2);
#pragma unroll
        for (int t = 0; t < 64; ++t) x2[t] = -x2[t]; } }
    asm volatile("s_waitcnt vmcnt(0) lgkmcnt(0)" ::: "memory");
    RK_FENCE();
    f32x2 xs[64];
    { const GAS bf16_t* SKKe = (const GAS bf16_t*)(cs + S_KKE);
#pragma unroll
      for (int t = 0; t < 64; ++t) { xs[t].x = bf2f(SKKe[t * 64 + lane]); xs[t].y = x2[t]; } }
    RK_FENCE();
#pragma unroll
    for (int tm = 0; tm < 2; ++tm) { float Mh[32];
        { f32x16 c0 = Z, c1 = Z;
#pragma unroll
          for (int s = 0; s < 4; ++s) { const frag ka = *(const GAS frag*)((const GAS bf16_t*)(cs + S_KKE) + (32 * tm + l31) * 64 + 16 * s + 8 * hi);
              const frag b0 = *(const GAS frag*)((const GAS bf16_t*)(cs + S_BI) + l31 * 64 + 16 * s + 8 * hi);
              c0 = mma(ka, b0, c0);
              if (tm == 1) { const frag b1 = *(const GAS frag*)((const GAS bf16_t*)(cs + S_BI) + (32 + l31) * 64 + 16 * s + 8 * hi); c1 = mma(ka, b1, c1); } }
          asm volatile("s_nop 15\n\ts_nop 15" : "+v"(c0), "+v"(c1));
#pragma unroll
          for (int r = 0; r < 16; ++r) { float a = c0[r], b = c1[r]; swap32f(a, b); Mh[crow(r, 0)] = a; Mh[crow(r, 1)] = b; } }
        RK_FENCE();
#pragma unroll
        for (int tl = 0; tl < 32; ++tl) { const int t = 32 * tm + tl; if (t == 0) continue; f32x2 sacc = {0.f, 0.f};
#pragma unroll
            for (int i = 0; i < t; ++i) { const float m = __uint_as_float((unsigned)__builtin_amdgcn_readlane((int)__float_as_uint(Mh[tl]), i)); sacc += xs[i] * m;
                if ((i & 15) == 15) RK_FENCE(); }
            xs[t] -= sacc; RK_FENCE(); } }
    float kke[64];
#pragma unroll
    for (int t = 0; t < 64; ++t) { kke[t] = xs[t].x; x2[t] = xs[t].y; }
    asm volatile("" : "+v"(lane)); cs = launder(cs); l31 = lane & 31; hi = lane >> 5;
    frag WB[4][2], U0B[4][2]; lc_to_frags(kke, WB); lc_to_frags(x2, U0B);
    RK_FENCE();
    { f32x16 QT[2][2];
      { frag BiB[4][2];
#pragma unroll
        for (int ks = 0; ks < 4; ++ks) { BiB[ks][0] = load_frag(cs + F_BIB, 2 * ks, lane); BiB[ks][1] = load_frag(cs + F_BIB, 2 * ks + 1, lane); }
#pragma unroll
        for (int tm = 0; tm < 2; ++tm)
#pragma unroll
            for (int tn = 0; tn < 2; ++tn) { f32x16 a = Z;
#pragma unroll
                for (int ks = 0; ks < 4; ++ks) a = mma(WB[ks][tm], BiB[ks][tn], a);
                const float dlc = __shfl(DL, 32 * tn + l31);
#pragma unroll
                for (int r = 0; r < 16; ++r) a[r] = ((tm == tn && crow(r, hi) == l31 ? 1.f : 0.f) - a[r]) * dlc;
                dump_frag(cs + O_P, (2 * tm) * 2 + tn, lane, pack_half(a, 0)); dump_frag(cs + O_P, (2 * tm + 1) * 2 + tn, lane, pack_half(a, 1)); RK_FENCE(); }
#pragma unroll
        for (int tm = 0; tm < 2; ++tm)
#pragma unroll
            for (int tn = 0; tn < 2; ++tn) { QT[tm][tn] = Z;
#pragma unroll
                for (int ks = 0; ks < 4; ++ks) QT[tm][tn] = mma(BiB[ks][tm], U0B[ks][tn], QT[tm][tn]); }
        RK_FENCE(); }
#pragma unroll
      for (int ks = 0; ks < 4; ++ks) { frag kib[2], vb[2];
#pragma unroll
          for (int t2 = 0; t2 < 2; ++t2) { kib[t2] = load_frag(cs + F_KIB, 2 * ks + t2, lane); vb[t2] = load_frag(cs + F_VB, 2 * ks + t2, lane); }
#pragma unroll
          for (int tm = 0; tm < 2; ++tm)
#pragma unroll
              for (int tn = 0; tn < 2; ++tn) QT[tm][tn] = mma(kib[tm], vb[tn], QT[tm][tn]);
          RK_FENCE(); }
#pragma unroll
      for (int tm = 0; tm < 2; ++tm)
#pragma unroll
          for (int tn = 0; tn < 2; ++tn) {
#pragma unroll
              for (int r = 0; r < 16; ++r) { const float d0 = __uint_as_float((unsigned)__builtin_amdgcn_readlane((int)__float_as_uint(DL), 32 * tm + crow(r, 0))), d1 = __uint_as_float((unsigned)__builtin_amdgcn_readlane((int)__float_as_uint(DL), 32 * tm + crow(r, 1)));
                  QT[tm][tn][r] *= hi ? d1 : d0; }
              dump_tile_f32(cs + O_QT, tm * 2 + tn, lane, QT[tm][tn]); }
      RK_FENCE(); }
#pragma unroll
    for (int mt = 0; mt < 2; ++mt) { f32x16 a0 = Z, a1 = Z;
#pragma unroll
        for (int ks = 0; ks < 4; ++ks) if (mt == 1 || ks < 2) { const frag arb = load_frag(cs + F_ARBA, ks * 2 + mt, lane), ark = load_frag(cs + F_ARKA, ks * 2 + mt, lane);
            const frag v0 = load_frag(cs + F_VB, 2 * ks, lane), v1 = load_frag(cs + F_VB, 2 * ks + 1, lane);
            a0 = mma(arb, U0B[ks][0], a0); a0 = mma(ark, v0, a0); a1 = mma(arb, U0B[ks][1], a1); a1 = mma(ark, v1, a1); }
        dump_tile_f32(cs + O_Y0, mt * 2, lane, a0); dump_tile_f32(cs + O_Y0, mt * 2 + 1, lane, a1); RK_FENCE(); }
    { const GAS bf16_t* SRd = (const GAS bf16_t*)(cs + S_RD);
#pragma unroll
      for (int tn = 0; tn < 2; ++tn) { f32x16 a[2] = {Z, Z};
#pragma unroll
          for (int ks = 0; ks < 4; ++ks) if (tn == 1 || ks < 2) { const frag arb = load_frag(cs + F_ARBA, ks * 2 + tn, lane); a[0] = mma(WB[ks][0], arb, a[0]); a[1] = mma(WB[ks][1], arb, a[1]); }
#pragma unroll
          for (int tm = 0; tm < 2; ++tm) {
#pragma unroll
              for (int q = 0; q < 4; ++q) { const u32x2 w = *(const GAS u32x2*)(SRd + (32 * tn + l31) * 64 + 32 * tm + 8 * q + 4 * hi);
                  a[tm][4 * q] = bf2f(w.x & 0xffffu) - a[tm][4 * q]; a[tm][4 * q + 1] = bf2f(w.x >> 16) - a[tm][4 * q + 1]; a[tm][4 * q + 2] = bf2f(w.y & 0xffffu) - a[tm][4 * q + 2]; a[tm][4 * q + 3] = bf2f(w.y >> 16) - a[tm][4 * q + 3]; }
              dump_frag(cs + O_GA, (2 * tm) * 2 + tn, lane, pack_half(a[tm], 0)); dump_frag(cs + O_GA, (2 * tm + 1) * 2 + tn, lane, pack_half(a[tm], 1)); }
          RK_FENCE(); } }
#undef RK_FENCE
}

__device__ __forceinline__ void r2_chain(const Params& p, int bh, int lane) {
    unsigned char* ws = p.ws; const int b = bh >> 3, h = bh & 7;
    f32x16 S[2][2];
#pragma unroll
    for (int i = 0; i < 2; ++i)
#pragma unroll
        for (int j = 0; j < 2; ++j) S[i][j] = f32x16{};
    frag PA[4][2]; f32x16 QT[2][2];
    { const GAS unsigned char* cs = (const GAS unsigned char*)(ws + WS_RW + (size_t)((b * 64) * 8 + h) * CELL);
#pragma unroll
      for (int ks = 0; ks < 4; ++ks) { PA[ks][0] = load_frag(cs + O_P, ks * 2, lane); PA[ks][1] = load_frag(cs + O_P, ks * 2 + 1, lane); }
#pragma unroll
      for (int t = 0; t < 4; ++t) QT[t >> 1][t & 1] = load_tile_f32(cs + O_QT, t, lane); }
#pragma nounroll
    for (int cidx = 0; cidx < 64; ++cidx) {
        GAS unsigned char* cs = (GAS unsigned char*)(ws + WS_RW + (size_t)((b * 64 + cidx) * 8 + h) * CELL);
        const GAS unsigned char* cn = (const GAS unsigned char*)(ws + WS_RW + (size_t)((b * 64 + (cidx < 63 ? cidx + 1 : cidx)) * 8 + h) * CELL);
        frag SB[4][2];
#pragma unroll
        for (int tm = 0; tm < 2; ++tm)
#pragma unroll
            for (int tn = 0; tn < 2; ++tn) { SB[2 * tm][tn] = pack_half(S[tm][tn], 0); SB[2 * tm + 1][tn] = pack_half(S[tm][tn], 1); }
#pragma unroll
        for (int ks = 0; ks < 4; ++ks) { dump_frag(cs + O_S0B, ks * 2, lane, SB[ks][0]); dump_frag(cs + O_S0B, ks * 2 + 1, lane, SB[ks][1]); }
        frag PN[4][2]; f32x16 QN[2][2];
#pragma unroll
        for (int ks = 0; ks < 4; ++ks) { PN[ks][0] = load_frag(cn + O_P, ks * 2, lane); PN[ks][1] = load_frag(cn + O_P, ks * 2 + 1, lane); }
#pragma unroll
        for (int t = 0; t < 4; ++t) QN[t >> 1][t & 1] = load_tile_f32(cn + O_QT, t, lane);
#pragma unroll
        for (int tm = 0; tm < 2; ++tm)
#pragma unroll
            for (int tn = 0; tn < 2; ++tn) { f32x16 a = QT[tm][tn];
#pragma unroll
                for (int ks = 0; ks < 4; ++ks) a = mma(PA[ks][tm], SB[ks][tn], a);
                S[tm][tn] = a; }
#pragma unroll
        for (int ks = 0; ks < 4; ++ks) { PA[ks][0] = PN[ks][0]; PA[ks][1] = PN[ks][1]; }
#pragma unroll
        for (int t = 0; t < 4; ++t) QT[t >> 1][t & 1] = QN[t >> 1][t & 1];
    }
}

__device__ __forceinline__ void r3_cell(const Params& p, int chunk, int h, int lane) {
    asm volatile("" : "+v"(lane));
    unsigned char* ws = launder(p.ws); const bf16_t* PRW = (const bf16_t*)(ws + WS_PRW); const float* mu = launder(p.in[16]); const float* g2w = launder(p.in[21]);
    const int l31 = lane & 31, hi = lane >> 5, row0 = chunk * 64; const bool first = (row0 % SEQ) == 0; const int cell = chunk * 8 + h;
    const GAS unsigned char* cs = (const GAS unsigned char*)(ws + WS_RW + (size_t)cell * CELL);
    f32x16 Y[2][2];
    { frag GA[4][2], SB[4][2];
#pragma unroll
      for (int ks = 0; ks < 4; ++ks) { GA[ks][0] = load_frag(cs + O_GA, ks * 2, lane); GA[ks][1] = load_frag(cs + O_GA, ks * 2 + 1, lane); SB[ks][0] = load_frag(cs + O_S0B, ks * 2, lane); SB[ks][1] = load_frag(cs + O_S0B, ks * 2 + 1, lane); }
#pragma unroll
      for (int tm = 0; tm < 2; ++tm)
#pragma unroll
          for (int tn = 0; tn < 2; ++tn) { f32x16 a = load_tile_f32(cs + O_Y0, tm * 2 + tn, lane);
#pragma unroll
              for (int ks = 0; ks < 4; ++ks) a = mma(GA[ks][tm], SB[ks][tn], a);
              Y[tm][tn] = a; } }
    f32x16 Gt[2][2];
#pragma unroll
    for (int i = 0; i < 2; ++i)
#pragma unroll
        for (int j = 0; j < 2; ++j) Gt[i][j] = f32x16{};
#pragma unroll
    for (int s = 0; s < 8; ++s) { frag Ag[2];
#pragma unroll
        for (int tm = 0; tm < 2; ++tm) { const int tl = 32 * tm + l31; float x[8]; shift8(PRW, row0 + tl, !(first && tl == 0), 1664 + 16 * s + 8 * hi, mu, x);
            Ag[tm] = mkfrag(cvt_pk_bf16(fsigm(x[0]), fsigm(x[1])), cvt_pk_bf16(fsigm(x[2]), fsigm(x[3])), cvt_pk_bf16(fsigm(x[4]), fsigm(x[5])), cvt_pk_bf16(fsigm(x[6]), fsigm(x[7]))); }
#pragma unroll
        for (int tn = 0; tn < 2; ++tn) { const frag Bg = colfrag(g2w, 512, 16 * s + 8 * hi, h * 64 + 32 * tn + l31);
#pragma unroll
            for (int tm = 0; tm < 2; ++tm) Gt[tm][tn] = mma(Ag[tm], Bg, Gt[tm][tn]); } }
    bf16_t* ACAT = (bf16_t*)(ws + WS_ACAT); const GAS float* BON = (const GAS float*)(ws + WS_BON) + cell * 64;
    float lw[2], lb[2];
#pragma unroll
    for (int tn = 0; tn < 2; ++tn) { lw[tn] = p.in[25][h * 64 + 32 * tn + l31]; lb[tn] = p.in[26][h * 64 + 32 * tn + l31]; }
#pragma unroll
    for (int tm = 0; tm < 2; ++tm) { frag VB[2][2];
#pragma unroll
        for (int half = 0; half < 2; ++half)
#pragma unroll
            for (int tn = 0; tn < 2; ++tn) VB[half][tn] = load_frag(cs + F_VB, (2 * tm + half) * 2 + tn, lane);
#pragma unroll
        for (int r = 0; r < 16; ++r) { const int t = 32 * tm + crow(r, hi);
            float s = Y[tm][0][r] + Y[tm][1][r];
#pragma unroll
            for (int off = 1; off < 32; off <<= 1) s += __shfl_xor(s, off);
            const float mean = s * (1.f / 64.f); const float d0 = Y[tm][0][r] - mean, d1 = Y[tm][1][r] - mean; float q = d0 * d0 + d1 * d1;
#pragma unroll
            for (int off = 1; off < 32; off <<= 1) q += __shfl_xor(q, off);
            const float rs = __builtin_amdgcn_rsqf(q * (1.f / 64.f) + 64e-5f), bon = BON[t];
#pragma unroll
            for (int tn = 0; tn < 2; ++tn) { const unsigned short vb = (unsigned short)VB[r >> 3][tn][r & 7]; const float v = bf2f((unsigned)vb);
                const float yn = (tn ? d1 : d0) * rs * lw[tn] + lb[tn];
#if defined(RK_PROBE) && !defined(RK_PROBE_SWAP)
                ((bf16_t*)(ws + WS_ACAT2))[(size_t)(row0 + t) * 512 + h * 64 + 32 * tn + l31] = (bf16_t)f2bf((yn + bon * v) * Gt[tm][tn][r]); } } }
#else
                ACAT[(size_t)(row0 + t) * 1024 + 512 + h * 64 + 32 * tn + l31] = (bf16_t)f2bf((yn + bon * v) * Gt[tm][tn][r]); } } }
#endif
}
}
__device__ __forceinline__ void phase_topk(const Params& p, int G, int wave, int lane) {
    unsigned char* ws = p.ws; const float* LOGIT = (const float*)(ws + WS_MIXF); const float* rb = p.in[32];
    unsigned* CNT = (unsigned*)(ws + WS_CTL) + CW_CNT; int* ROWMAP = (int*)(ws + WS_ROWMAP); float* ROWW = (float*)(ws + WS_ROWW);
    const float NEG = -INFINITY; const f32x4 rb4 = *(const f32x4*)(rb + 4 * lane);
    for (int row = blockIdx.x * 8 + wave; row < M; row += G * 8) {
        f32x4 l4 = *(const f32x4*)(LOGIT + (size_t)row * 256 + 4 * lane);
#pragma unroll
        for (int pp = 1; pp < 4; ++pp) l4 += *(const f32x4*)(LOGIT + ((size_t)pp * M + row) * 256 + 4 * lane);
        float sc[4], cand[4];
#pragma unroll
        for (int j = 0; j < 4; ++j) { sc[j] = sigmoidf_(l4[j]); cand[j] = sc[j] + rb4[j]; }
        float m1, m2; { const float a = fmaxf(cand[0], cand[1]), c2 = fminf(cand[0], cand[1]), d = fmaxf(cand[2], cand[3]), e2 = fminf(cand[2], cand[3]); m1 = fmaxf(a, d); m2 = fmaxf(fminf(a, d), fmaxf(c2, e2)); }
#pragma unroll
        for (int off = 1; off < 8; off <<= 1) { const float o1 = __shfl_xor(m1, off), o2 = __shfl_xor(m2, off); const float n1 = fmaxf(m1, o1), n2 = fmaxf(fminf(m1, o1), fmaxf(m2, o2)); m1 = n1; m2 = n2; }
        const float gs = m1 + m2; const int g = lane >> 3; int rank = 0;
#pragma unroll
        for (int gg = 0; gg < 8; ++gg) { const float og = __shfl(gs, gg * 8); rank += (og > gs || (og == gs && gg < g)) ? 1 : 0; }
        if (rank >= 4) {
#pragma unroll
            for (int j = 0; j < 4; ++j) cand[j] = NEG; }
        int myE = 0; float myS = 0.f, ssum = 0.f;
#pragma unroll
        for (int k = 0; k < 8; ++k) {
            float bv = cand[0]; int bi = 4 * lane;
#pragma unroll
            for (int j = 1; j < 4; ++j) if (cand[j] > bv) { bv = cand[j]; bi = 4 * lane + j; }
#pragma unroll
            for (int off = 1; off < 64; off <<= 1) { const float ov = __shfl_xor(bv, off); const int oi = __shfl_xor(bi, off); if (ov > bv || (ov == bv && oi < bi)) { bv = ov; bi = oi; } }
            const int owner = bi >> 2, jj = bi & 3;
            const float mine = jj == 0 ? sc[0] : jj == 1 ? sc[1] : jj == 2 ? sc[2] : sc[3];
            const float sk = __shfl(mine, owner);
            if (lane == owner) {
#pragma unroll
                for (int j = 0; j < 4; ++j) if (j == jj) cand[j] = NEG; }
            ssum += sk; if (lane == k) { myE = bi; myS = sk; }
        }
        if (lane < 8) { const float w = myS / ssum * 2.5f; const unsigned pos = __hip_atomic_fetch_add(CNT + myE, 1u, RLX_AGENT);
            ROWMAP[myE * CAP + pos] = row * 16 + lane; ROWW[myE * CAP + pos] = w; }
    }
}
__device__ __forceinline__ void phase_combine(const Params& p, int G, int tid) {
    unsigned char* ws = p.ws; const float* X1 = (const float*)(ws + WS_X1); const float* MODF = (const float*)(ws + WS_MODF); const bf16_t* YS = (const bf16_t*)(ws + WS_YS);
    for (int idx = blockIdx.x * 512 + tid; idx < M * 128; idx += G * 512) { const int row = idx >> 7, col = (idx & 127) * 8, b = row / SEQ;
        f32x4 a0 = {0.f, 0.f, 0.f, 0.f}, a1 = {0.f, 0.f, 0.f, 0.f};
#pragma unroll
        for (int s = 0; s < 9; ++s) { f32x4 t0, t1; unpack8(*(const u32x4*)(YS + ((size_t)row * 9 + s) * 1024 + col), t0, t1); a0 += t0; a1 += t1; }
        const f32x4 g0 = *(const f32x4*)(MODF + b * 6144 + 5120 + col), g1 = *(const f32x4*)(MODF + b * 6144 + 5120 + col + 4);
        const size_t o = (size_t)row * D + col;
#ifdef RK_PROBE
#ifdef PROBE_STAT
        { const unsigned cks = ((const unsigned*)(ws + WS_CTL))[CW_PROBE + 4]; const float pert = 1.f + 0.03f * (float)(cks & 0xffffu) * (1.f / 65536.f);
#else
        { const float* acc = (const float*)(ws + WS_CTL) + CW_PROBE; const float pert = 1.f + (acc[2] > 0.f ? 100.f : 10.f * sqrtf(acc[0] / acc[1]));
#endif
          *(f32x4*)(p.out + o) = (*(const f32x4*)(X1 + o) + g0 * a0) * pert; *(f32x4*)(p.out + o + 4) = (*(const f32x4*)(X1 + o + 4) + g1 * a1) * pert; } }
#else
        *(f32x4*)(p.out + o) = *(const f32x4*)(X1 + o) + g0 * a0; *(f32x4*)(p.out + o + 4) = *(const f32x4*)(X1 + o + 4) + g1 * a1; }
#endif
}

__global__ void __launch_bounds__(512, 2) hybrid_fwd(Params p) {
    extern __shared__ __attribute__((aligned(16))) unsigned char lds_raw[];
    LAS unsigned char* lds = (LAS unsigned char*)lds_raw;
    const int tid = threadIdx.x, lane = tid & 63, wave = __builtin_amdgcn_readfirstlane(tid >> 6), G = gridDim.x;
    unsigned char* ws = p.ws; unsigned* ctl = (unsigned*)(ws + WS_CTL);
    for (int u = tid; u < (LDS_BYTES - LDSCTL_OFF) / 4; u += 512) ((LAS unsigned*)(lds + LDSCTL_OFF))[u] = 0u;
    __syncthreads();
    XcdBarrier bar; bar.bar = ctl + CW_BAR; bar.x = 0; bar.st = nullptr;
    if (MK_ONE_LAUNCH) bar = xcd_barrier_post(ctl + CW_BAR, (volatile LAS unsigned*)(lds + MISC_OFF) + 8);
    const int lo = p.ph_lo, hi = p.ph_hi;
#define IN(k) (lo <= (k) && (k) < hi)
#ifndef REPEAT_PHASE
#define REPEAT_PHASE -1
#endif
#define REP(k) for (int rep_ = 0; rep_ < ((REPEAT_PHASE) == (k) ? 2 : 1); ++rep_)
#define SEAM(k) do { if (MK_ONE_LAUNCH && IN(k) && IN((k) + 1)) xcd_barrier(bar); } while (0)

    if (IN(0)) { REP(0) { phase_prologue(p, lds, G, wave, lane); __syncthreads(); } } SEAM(0);
    if (IN(1)) { REP(1) { phase_norm1(p, lds, G, tid, wave, lane); __syncthreads(); } } SEAM(1);
    if (IN(2)) {
        pg8::PlainOrder S; S.init(ws + WS_XN, ws + WS_W1T, M, N1, 1024, 1024, G, (int)blockIdx.x);
        EpiG1 E{ws, p.in[9], p.in[10], (const float*)(ws + WS_COS), (const float*)(ws + WS_SIN), p.in[8]};
        REP(2) pg8::gemm_phase<EpiG1, pg8::PlainOrder, true, false>(lds, 1024, 1024, 1024, S, E);
    } SEAM(2);
    if (IN(3)) { REP(30) for (int chunk = blockIdx.x; chunk < M / 64; chunk += G) rk::r1_cell(p, chunk, wave, lds, lane); } SEAM(3);
    if (IN(4)) {
        if (blockIdx.x < 32 && wave == 0) rk::r2_chain(p, (int)blockIdx.x, lane);
        const float lam = ((const float*)(ws + WS_SCAL))[0];
        volatile LAS int* qslot = (volatile LAS int*)(lds + MISC_OFF) + 16;
        REP(31) for (;;) {
            __syncthreads();
            if (tid == 0) qslot[0] = (int)__hip_atomic_fetch_add(ctl + CW_ATTQ + (REPEAT_PHASE == 31 ? 64 * rep_ : 0), 1u, RLX_AGENT);
            __syncthreads();
            const int u = qslot[0];
            if (u >= 512) break;
            const int bh = u & 15, qb = 31 - (u >> 4);
            att::attn_unit(bh >> 2, bh & 3, qb, (const bf16_t*)(ws + WS_QN), (const bf16_t*)(ws + WS_KN), (const bf16_t*)(ws + WS_VB), (bf16_t*)(ws + WS_ACAT), p.in[15], lam, lds);
        }
    } SEAM(4);
    if (IN(5)) { REP(5) for (int chunk = blockIdx.x; chunk < M / 64; chunk += G) rk::r3_cell(p, chunk, wave, lane);
#ifdef RK_PROBE
        rwkv_post(p, G, wave, lane);
#endif
    } SEAM(5);
    if (IN(6)) {
#ifdef RK_PROBE
        probe_compare(p, G, tid);
#ifdef PROBE_STAT
        probe_checksum(p, G, tid);
#endif
#endif
        BranchOrder S{(const char*)(ws + WS_ACAT), (const char*)(ws + WS_WAT), (const char*)(ws + WS_WBT), G, (int)blockIdx.x};
        EpiBranch E{(const bf16_t*)(ws + WS_GATE), (float*)(ws + WS_MIXF), (bf16_t*)(ws + WS_MIX)};
        REP(6) pg8::gemm_phase<EpiBranch, BranchOrder, true, false>(lds, 512, 1024, 512, S, E);
    } SEAM(6);
    if (IN(7)) {
        pg8::PlainOrder S; S.init(ws + WS_MIX, ws + WS_WOT, M, 1024, 1024, 1024, G, (int)blockIdx.x);
        EpiOut E{p.in[0], (const float*)(ws + WS_MODF), (float*)(ws + WS_X1)};
        REP(7) pg8::gemm_phase<EpiOut, pg8::PlainOrder, true, false>(lds, 1024, 1024, 1024, S, E);
    } SEAM(7);
    if (IN(8)) { REP(8) { phase_norm2(p, lds, G, tid, wave, lane); __syncthreads(); } } SEAM(8);
    if (IN(9)) {
        RouterOrder S{(const char*)(ws + WS_H2), (const char*)(ws + WS_WRT), G, (int)blockIdx.x};
        EpiF32P E{(float*)(ws + WS_MIXF)};
        REP(9) pg8::gemm_phase<EpiF32P, RouterOrder, true, false>(lds, 768, 3072, 3072, S, E);
    } SEAM(9);
    if (IN(10)) { phase_topk(p, G, wave, lane); } SEAM(10);
    if (IN(11)) {
        moe_tables(ctl + CW_CNT, lds, tid);
        const LAS int* pref = (const LAS int*)(lds + MOE_OFF);
        MoeUpOrder S{pref, pref + 260, (const int*)(ws + WS_ROWMAP), (const char*)(ws + WS_H2), (const char*)(ws + WS_WEU), G, (int)blockIdx.x};
        EpiUp E{pref, (bf16_t*)(ws + WS_HID)};
        REP(11) pg8::gemm_phase<EpiUp, MoeUpOrder, true, true>(lds, 1024, 3072, 1024, S, E);
    } SEAM(11);
    if (IN(12)) {
        moe_tables(ctl + CW_CNT, lds, tid);
        const LAS int* pref = (const LAS int*)(lds + MOE_OFF);
        MoeDownOrder S{pref, (const char*)(ws + WS_HID), (const char*)(ws + WS_WED), G, (int)blockIdx.x};
        EpiDown E{pref + 260, (const int*)(ws + WS_ROWMAP), (const float*)(ws + WS_ROWW), (bf16_t*)(ws + WS_YS)};
        REP(12) pg8::gemm_phase<EpiDown, MoeDownOrder, true, false>(lds, 256, 256, 256, S, E);
    } SEAM(12);
    if (IN(13)) { REP(13) phase_combine(p, G, tid); }
#undef IN
#undef SEAM
}

extern "C" void kernel_launch(void* const* d_in, const int* in_sizes, int n_in, void* d_out, int out_size, void* d_ws, size_t ws_size, hipStream_t stream) {
    static int grid = 0;
    if (grid == 0) {
        if (n_in != 37 || in_sizes[0] != M * D || out_size != M * D || ws_size < WS_END) { fprintf(stderr, "kernel_launch: unexpected sizes (n_in %d, in0 %d, out %d, ws %zu, need %zu); nothing launched\n", n_in, n_in > 0 ? in_sizes[0] : -1, out_size, ws_size, (size_t)WS_END); grid = -1; return; }
        int dev = 0, cus = 0, per_cu = 0;
        if (hipGetDevice(&dev) != hipSuccess || hipDeviceGetAttribute(&cus, hipDeviceAttributeMultiprocessorCount, dev) != hipSuccess) { grid = -1; return; }
        if (hipFuncSetAttribute((const void*)hybrid_fwd, hipFuncAttributeMaxDynamicSharedMemorySize, LDS_BYTES) != hipSuccess) { fprintf(stderr, "kernel_launch: hipFuncSetAttribute failed\n"); grid = -1; return; }
        if (hipOccupancyMaxActiveBlocksPerMultiprocessor(&per_cu, (const void*)hybrid_fwd, 512, LDS_BYTES) != hipSuccess || per_cu < 1) fprintf(stderr, "kernel_launch: occupancy query reports %d\n", per_cu);
        (void)hipGetLastError();
        grid = cus;
        if (grid != 256) fprintf(stderr, "kernel_launch: %d CUs (built for 256)\n", grid);
    }
    if (grid < 0) return;
    if (hipMemsetAsync((char*)d_ws + WS_CTL, 0, CTL_ZERO_BYTES, stream) != hipSuccess) return;
    Params a{};
    for (int i = 0; i < 37; ++i) a.in[i] = (const float*)d_in[i];
    a.out = (float*)d_out; a.ws = (unsigned char*)d_ws;
#if MK_ONE_LAUNCH
    a.ph_lo = 0; a.ph_hi = NPHASE;
    hipLaunchKernelGGL(hybrid_fwd, dim3(grid), dim3(512), LDS_BYTES, stream, a);
#else
    for (int ph = 0; ph < NPHASE; ++ph) { a.ph_lo = ph; a.ph_hi = ph + 1; hipLaunchKernelGGL(hybrid_fwd, dim3(grid), dim3(512), LDS_BYTES, stream, a); }
#endif
}
```
